# Optimizing an MI355X kernel written in HIP

```python
import math
import jax, jax.numpy as jnp
from jax import lax
import numpy as np

D_MODEL = 1024
BATCH = 8
SEQ = 4096
DEPTH = 2

GRID_W = 64
CTX_LEN = 256
N_BRANCH = 4
BRANCH_W = D_MODEL // 4
HEAD_DIM = 64
NA_HEADS = BRANCH_W // HEAD_DIM
WIN_H = 8
WIN_W = 16
MLA_HEADS = 4
MLA_NOPE = 64
MLA_ROPE = 32
MLA_V = BRANCH_W // MLA_HEADS
MLA_Q_LORA = 256
MLA_KV_LORA = 128
LRU_W = BRANCH_W
LRU_BLOCKS = 4
LRU_BW = LRU_W // LRU_BLOCKS
CONV_W = 4
LRU_C = 8.0
GQA_HEADS = BRANCH_W // HEAD_DIM
GQA_KV_HEADS = 2
ROPE_THETA = 10000.0
Q_BLOCK = 128
EPS = 1e-6
NA_SCALE = HEAD_DIM ** -0.5
MLA_SCALE = (MLA_NOPE + MLA_ROPE) ** -0.5
GQA_SCALE = HEAD_DIM ** -0.5
DEEPNORM_ALPHA = (2 * DEPTH) ** 0.25
DEEPNORM_BETA = (8 * DEPTH) ** -0.25

MIX_SPLITS = (BRANCH_W, BRANCH_W, BRANCH_W,
              MLA_Q_LORA, MLA_KV_LORA, MLA_ROPE,
              LRU_W,
              GQA_HEADS * HEAD_DIM, GQA_KV_HEADS * HEAD_DIM, GQA_KV_HEADS * HEAD_DIM)
MIX_COLS = sum(MIX_SPLITS)
SILU_COLS = N_BRANCH * BRANCH_W
MERGE_COLS = N_BRANCH * D_MODEL
N_IN = MIX_COLS + SILU_COLS + MERGE_COLS

kernel_name = "hybrid_na_mla_rglru_gqa_prefix_block"


def layer_norm(x, eps=EPS):
    xf = x.astype(jnp.float32)
    mu = jnp.mean(xf, -1, keepdims=True)
    var = jnp.mean(jnp.square(xf - mu), -1, keepdims=True)
    return ((xf - mu) * lax.rsqrt(var + eps)).astype(x.dtype)


def rms_norm(x, g, eps=EPS):
    xf = x.astype(jnp.float32)
    y = xf * lax.rsqrt(jnp.mean(jnp.square(xf), -1, keepdims=True) + eps)
    return (y * g.astype(jnp.float32)).astype(x.dtype)


def rope_1d(x, pos):
    d = x.shape[-1]
    inv = ROPE_THETA ** (-jnp.arange(0, d, 2, dtype=jnp.float32) / d)
    ang = pos[:, None] * inv[None, :]
    cos, sin = jnp.cos(ang), jnp.sin(ang)
    xf = x.astype(jnp.float32)
    x1, x2 = xf[..., : d // 2], xf[..., d // 2:]
    return jnp.concatenate([x1 * cos - x2 * sin, x2 * cos + x1 * sin], -1).astype(x.dtype)


def axial_rope(x, rows, cols):
    half = x.shape[-1] // 2
    return jnp.concatenate([rope_1d(x[..., :half], rows), rope_1d(x[..., half:], cols)], -1)


def split_cols(p, sizes):
    out, start = [], 0
    for size in sizes:
        out.append(p[..., start:start + size])
        start += size
    return out


def split_heads(t, n_heads):
    b, n, _ = t.shape
    return t.reshape(b, n, n_heads, -1).transpose(0, 2, 1, 3)


def merge_heads(t):
    b, h, n, d = t.shape
    return t.transpose(0, 2, 1, 3).reshape(b, n, h * d)


def attend(q, keys, vals, scale):
    b, hq, nq, dk = q.shape
    hk = keys.shape[1]
    qg = q.reshape(b, hk, hq // hk, nq, dk)
    s = jnp.einsum('bkgqd,bknd->bkgqn', qg, keys, preferred_element_type=jnp.float32) * scale
    p = jax.nn.softmax(s, axis=-1).astype(vals.dtype)
    o = jnp.einsum('bkgqn,bknd->bkgqd', p, vals)
    return o.reshape(b, hq, nq, vals.shape[-1])


def prefix_attention(q, k, v, k_ctx, v_ctx, scale):
    b, hq, n, dk = q.shape
    keys = jnp.concatenate([k_ctx, k], axis=2)
    vals = jnp.concatenate([v_ctx, v], axis=2)
    nb = n // Q_BLOCK
    qb = q.reshape(b, hq, nb, Q_BLOCK, dk).transpose(2, 0, 1, 3, 4)
    out = lax.map(lambda qi: attend(qi, keys, vals, scale), qb)
    return out.transpose(1, 2, 0, 3, 4).reshape(b, hq, n, vals.shape[-1])


def neighbourhood_attention(q, k, v, k_ctx, v_ctx, rel_bias):
    b, h, n, hd = q.shape
    n_rows = n // GRID_W
    wh, ww = min(WIN_H, n_rows), WIN_W
    qg = q.reshape(b, h, n_rows, GRID_W, hd)
    kg = k.reshape(b, h, n_rows, GRID_W, hd)
    vg = v.reshape(b, h, n_rows, GRID_W, hd)
    col_start = np.clip(np.arange(GRID_W) - ww // 2, 0, GRID_W - ww)
    col_idx = col_start[:, None] + np.arange(ww)[None, :]
    dc = col_idx - np.arange(GRID_W)[:, None]
    row_start = np.clip(np.arange(n_rows) - wh // 2, 0, n_rows - wh)
    dr = row_start[:, None] + np.arange(wh)[None, :] - np.arange(n_rows)[:, None]
    bias = rel_bias[:, (dr + WIN_H - 1)[:, :, None, None], (dc + WIN_W - 1)[None, None, :, :]]
    bias = bias.transpose(1, 0, 3, 2, 4).reshape(n_rows, h, GRID_W, wh * ww)

    def row_fn(args):
        qr, rs, bias_r = args
        k_win = jnp.take(lax.dynamic_slice_in_dim(kg, rs, wh, axis=2), col_idx, axis=3)
        v_win = jnp.take(lax.dynamic_slice_in_dim(vg, rs, wh, axis=2), col_idx, axis=3)
        s_win = jnp.einsum('bhqd,bhiqjd->bhqij', qr, k_win, preferred_element_type=jnp.float32)
        s_win = s_win.reshape(b, h, GRID_W, wh * ww) * NA_SCALE + bias_r.astype(jnp.float32)
        s_ctx = jnp.einsum('bhqd,bhnd->bhqn', qr, k_ctx, preferred_element_type=jnp.float32) * NA_SCALE
        p = jax.nn.softmax(jnp.concatenate([s_win, s_ctx], -1), axis=-1).astype(v.dtype)
        p_win = p[..., :wh * ww].reshape(b, h, GRID_W, wh, ww)
        return (jnp.einsum('bhqij,bhiqjd->bhqd', p_win, v_win)
                + jnp.einsum('bhqn,bhnd->bhqd', p[..., wh * ww:], v_ctx))

    out = lax.map(row_fn, (qg.transpose(2, 0, 1, 3, 4), jnp.asarray(row_start, jnp.int32), bias))
    return out.transpose(1, 2, 0, 3, 4).reshape(b, h, n, hd)


def mla_project(cq, ckv, krope, q_norm, w_uq, kv_norm, w_ukv, rows, cols):
    b, n, _ = cq.shape
    q = (rms_norm(cq, q_norm) @ w_uq).reshape(b, n, MLA_HEADS, MLA_NOPE + MLA_ROPE).transpose(0, 2, 1, 3)
    kv = (rms_norm(ckv, kv_norm) @ w_ukv).reshape(b, n, MLA_HEADS, MLA_NOPE + MLA_V).transpose(0, 2, 1, 3)
    q_nope, q_rope = q[..., :MLA_NOPE], q[..., MLA_NOPE:]
    k_nope, v = kv[..., :MLA_NOPE], kv[..., MLA_NOPE:]
    if rows is not None:
        q_rope = axial_rope(q_rope, rows, cols)
        krope = axial_rope(krope, rows, cols)
    k_rope = jnp.broadcast_to(krope[:, None], (b, MLA_HEADS, n, MLA_ROPE))
    return (jnp.concatenate([q_nope, q_rope], -1), jnp.concatenate([k_nope, k_rope], -1), v)


def gqa_project(q, k, v, q_norm, k_norm, rows, cols):
    q = rms_norm(split_heads(q, GQA_HEADS), q_norm)
    k = rms_norm(split_heads(k, GQA_KV_HEADS), k_norm)
    v = split_heads(v, GQA_KV_HEADS)
    if rows is not None:
        q = axial_rope(q, rows, cols)
        k = axial_rope(k, rows, cols)
    return q, k, v


def centred_depthwise_conv(x, w, bias):
    pad_lo = CONV_W // 2
    y = lax.conv_general_dilated(x, w[:, None, :], window_strides=(1,),
                                 padding=[(pad_lo, CONV_W - 1 - pad_lo)],
                                 dimension_numbers=('NWC', 'WIO', 'NWC'),
                                 feature_group_count=x.shape[-1])
    return y + bias


def rglru_coeffs(x, w_a, b_a, w_x, b_x, lam):
    b, n, _ = x.shape
    xf = x.astype(jnp.float32)
    xb = xf.reshape(b, n, LRU_BLOCKS, LRU_BW)
    r = jax.nn.sigmoid(jnp.einsum('bnkc,kcd->bnkd', xb, w_a.astype(jnp.float32)).reshape(b, n, LRU_W) + b_a)
    i = jax.nn.sigmoid(jnp.einsum('bnkc,kcd->bnkd', xb, w_x.astype(jnp.float32)).reshape(b, n, LRU_W) + b_x)
    log_a = -LRU_C * r * jax.nn.softplus(-lam.astype(jnp.float32))
    a = jnp.exp(log_a)
    u = jnp.sqrt(-jnp.expm1(2.0 * log_a)) * (i * xf)
    return a, u


def linear_scan(a, u, h0, reverse):
    idx = -1 if reverse else 0
    u = u.at[:, idx].add(a[:, idx] * h0)

    def combine(lhs, rhs):
        a1, u1 = lhs
        a2, u2 = rhs
        return a1 * a2, a2 * u1 + u2

    _, h = lax.associative_scan(combine, (a, u), reverse=reverse, axis=1)
    return h


def rglru_mixer(x_lat, x_ctx, conv_w, conv_b, w_a, b_a, w_x, b_x, lam, need_ctx):
    xc = centred_depthwise_conv(x_ctx, conv_w, conv_b)
    xl = centred_depthwise_conv(x_lat, conv_w, conv_b)
    h_lat, h_ctx = [], []
    for d in range(2):
        reverse = d == 1
        end = 0 if reverse else -1
        a, u = rglru_coeffs(xc, w_a[d], b_a[d], w_x[d], b_x[d], lam[d])
        hc = linear_scan(a, u, jnp.zeros_like(a[:, 0]), reverse)
        a, u = rglru_coeffs(xl, w_a[d], b_a[d], w_x[d], b_x[d], lam[d])
        h_lat.append(linear_scan(a, u, hc[:, end], reverse))
        h_ctx.append(hc)
    y_lat = (h_lat[0] + h_lat[1]).astype(x_lat.dtype)
    y_ctx = (h_ctx[0] + h_ctx[1]).astype(x_ctx.dtype) if need_ctx else None
    return y_lat, y_ctx


def modulation(cond, w_mod, b_mod):
    mod = jax.nn.silu(cond) @ w_mod + b_mod
    return jnp.split(mod, 3, axis=-1)


def merge_branches(ys, z, m, w_branch, w_out):
    zs = jnp.split(z, N_BRANCH, axis=-1)
    ms = jnp.split(m, N_BRANCH, axis=-1)
    acc = sum(jax.nn.sigmoid(ms[i]) * ((ys[i] * jax.nn.silu(zs[i])) @ w_branch[i]) for i in range(N_BRANCH))
    return acc @ w_out


def hybrid_layer(x, ctx, c, c_ctx, w_mod, b_mod, w_in, na_rel_bias, mla_q_norm, mla_w_uq,
                 mla_kv_norm, mla_w_ukv, lru_conv_w, lru_conv_b, lru_w_a, lru_b_a, lru_w_x,
                 lru_b_x, lru_lambda, gqa_q_norm, gqa_k_norm, w_branch, w_out, ln_g, ln_b, need_ctx):
    n = x.shape[1]
    t = jnp.arange(n, dtype=jnp.int32)
    rows = (t // GRID_W).astype(jnp.float32)
    cols = (t % GRID_W).astype(jnp.float32)

    shift, scale, gate = modulation(c[:, None, :], w_mod, b_mod)
    shift_c, scale_c, gate_c = modulation(c_ctx, w_mod, b_mod)
    p_lat = (layer_norm(x) * (1.0 + scale) + shift) @ w_in
    w_in_ctx = w_in if need_ctx else w_in[:, :MIX_COLS]
    p_ctx = (layer_norm(ctx) * (1.0 + scale_c) + shift_c) @ w_in_ctx
    lat = split_cols(p_lat[..., :MIX_COLS], MIX_SPLITS)
    cx = split_cols(p_ctx[..., :MIX_COLS], MIX_SPLITS)

    q, k, v = (split_heads(tt, NA_HEADS) for tt in lat[0:3])
    qc, kc, vc = (split_heads(tt, NA_HEADS) for tt in cx[0:3])
    ya = merge_heads(neighbourhood_attention(q, k, v, kc, vc, na_rel_bias))
    ya_c = merge_heads(attend(qc, kc, vc, NA_SCALE)) if need_ctx else None

    q, k, v = mla_project(lat[3], lat[4], lat[5], mla_q_norm, mla_w_uq, mla_kv_norm, mla_w_ukv, rows, cols)
    qc, kc, vc = mla_project(cx[3], cx[4], cx[5], mla_q_norm, mla_w_uq, mla_kv_norm, mla_w_ukv, None, None)
    yb = merge_heads(prefix_attention(q, k, v, kc, vc, MLA_SCALE))
    yb_c = merge_heads(attend(qc, kc, vc, MLA_SCALE)) if need_ctx else None

    yc, yc_c = rglru_mixer(lat[6], cx[6], lru_conv_w, lru_conv_b, lru_w_a, lru_b_a,
                           lru_w_x, lru_b_x, lru_lambda, need_ctx)

    q, k, v = gqa_project(lat[7], lat[8], lat[9], gqa_q_norm, gqa_k_norm, rows, cols)
    qc, kc, vc = gqa_project(cx[7], cx[8], cx[9], gqa_q_norm, gqa_k_norm, None, None)
    yd = merge_heads(prefix_attention(q, k, v, kc, vc, GQA_SCALE))
    yd_c = merge_heads(attend(qc, kc, vc, GQA_SCALE)) if need_ctx else None

    z_lat = p_lat[..., MIX_COLS:MIX_COLS + SILU_COLS]
    m_lat = p_lat[..., MIX_COLS + SILU_COLS:]
    out = merge_branches([ya, yb, yc, yd], z_lat, m_lat, w_branch, w_out)
    x_new = layer_norm(DEEPNORM_ALPHA * x + gate * out) * ln_g + ln_b
    if need_ctx:
        z_c = p_ctx[..., MIX_COLS:MIX_COLS + SILU_COLS]
        m_c = p_ctx[..., MIX_COLS + SILU_COLS:]
        out_c = merge_branches([ya_c, yb_c, yc_c, yd_c], z_c, m_c, w_branch, w_out)
        ctx = layer_norm(DEEPNORM_ALPHA * ctx + gate_c * out_c) * ln_g + ln_b
    return x_new, ctx


def setup_inputs(seed: int = 0) -> dict:
    key = jax.random.key(seed)
    ks = jax.random.split(key, 32)
    f32 = jnp.float32
    L = DEPTH

    def nrm(k, shape, s):
        return jax.random.normal(k, shape, f32) * s

    lam_u = jax.random.uniform(ks[17], (L, 2, LRU_W), f32, 0.9, 0.999)
    a_base = lam_u ** (1.0 / LRU_C)
    lru_lambda = jnp.log(a_base) - jnp.log1p(-a_base)
    return {
        "x": nrm(ks[0], (BATCH, SEQ, D_MODEL), 1.0),
        "c": nrm(ks[1], (BATCH, D_MODEL), 1.0),
        "ctx": nrm(ks[2], (BATCH, CTX_LEN, D_MODEL), 1.0),
        "c_ctx": nrm(ks[3], (D_MODEL,), 1.0),
        "w_mod": nrm(ks[4], (L, D_MODEL, 3 * D_MODEL), 0.5 * D_MODEL ** -0.5),
        "b_mod": nrm(ks[5], (L, 3 * D_MODEL), 0.01),
        "w_in": nrm(ks[6], (L, D_MODEL, N_IN), D_MODEL ** -0.5),
        "na_rel_bias": nrm(ks[7], (L, NA_HEADS, 2 * WIN_H - 1, 2 * WIN_W - 1), 0.1),
        "mla_q_norm": 1.0 + nrm(ks[8], (L, MLA_Q_LORA), 0.01),
        "mla_w_uq": nrm(ks[9], (L, MLA_Q_LORA, MLA_HEADS * (MLA_NOPE + MLA_ROPE)), MLA_Q_LORA ** -0.5),
        "mla_kv_norm": 1.0 + nrm(ks[10], (L, MLA_KV_LORA), 0.01),
        "mla_w_ukv": nrm(ks[11], (L, MLA_KV_LORA, MLA_HEADS * (MLA_NOPE + MLA_V)), MLA_KV_LORA ** -0.5),
        "lru_conv_w": nrm(ks[12], (L, CONV_W, LRU_W), CONV_W ** -0.5),
        "lru_conv_b": nrm(ks[13], (L, LRU_W), 0.01),
        "lru_w_a": nrm(ks[14], (L, 2, LRU_BLOCKS, LRU_BW, LRU_BW), LRU_BW ** -0.5),
        "lru_b_a": nrm(ks[15], (L, 2, LRU_W), 0.01),
        "lru_w_x": nrm(ks[16], (L, 2, LRU_BLOCKS, LRU_BW, LRU_BW), LRU_BW ** -0.5),
        "lru_b_x": nrm(ks[18], (L, 2, LRU_W), 0.01),
        "lru_lambda": lru_lambda,
        "gqa_q_norm": 1.0 + nrm(ks[19], (L, HEAD_DIM), 0.01),
        "gqa_k_norm": 1.0 + nrm(ks[20], (L, HEAD_DIM), 0.01),
        "w_branch": nrm(ks[21], (L, N_BRANCH, BRANCH_W, D_MODEL), DEEPNORM_BETA * BRANCH_W ** -0.5),
        "w_out": nrm(ks[22], (L, D_MODEL, D_MODEL), DEEPNORM_BETA * D_MODEL ** -0.5),
        "ln_g": 1.0 + nrm(ks[23], (L, D_MODEL), 0.01),
        "ln_b": nrm(ks[24], (L, D_MODEL), 0.01),
    }


def reference(x, c, ctx, c_ctx, w_mod, b_mod, w_in, na_rel_bias, mla_q_norm, mla_w_uq,
              mla_kv_norm, mla_w_ukv, lru_conv_w, lru_conv_b, lru_w_a, lru_b_a, lru_w_x,
              lru_b_x, lru_lambda, gqa_q_norm, gqa_k_norm, w_branch, w_out, ln_g, ln_b):
    for l in range(DEPTH):
        need_ctx = l < DEPTH - 1
        x, ctx = hybrid_layer(x, ctx, c, c_ctx, w_mod[l], b_mod[l], w_in[l], na_rel_bias[l],
                              mla_q_norm[l], mla_w_uq[l], mla_kv_norm[l], mla_w_ukv[l],
                              lru_conv_w[l], lru_conv_b[l], lru_w_a[l], lru_b_a[l], lru_w_x[l],
                              lru_b_x[l], lru_lambda[l], gqa_q_norm[l], gqa_k_norm[l],
                              w_branch[l], w_out[l], ln_g[l], ln_b[l], need_ctx)
    return x
```

```cpp
#include <hip/hip_runtime.h>
#include <hip/hip_cooperative_groups.h>
#include <cstdio>
namespace cg = cooperative_groups;

#ifndef MULTI
#define MULTI 0
#endif
#ifndef ZERO_MASK
#define ZERO_MASK 0
#endif
#ifndef DUP_PHASE
#define DUP_PHASE 0
#endif
#ifndef DUP_MIX
#define DUP_MIX 0
#endif

typedef unsigned short u16;
using bf16x8 = __attribute__((ext_vector_type(8))) short;
using f32x16 = __attribute__((ext_vector_type(16))) float;
#define DI __device__ __forceinline__
#define MFMA(a, b, c) __builtin_amdgcn_mfma_f32_32x32x16_bf16((a), (b), (c), 0, 0, 0)

constexpr int DM = 1024, NBATCH = 8, SEQ = 4096, CTXL = 256, SEQA = 4352, R = NBATCH * SEQA;
constexpr int NIN = 7072, PKW = 1792, PTW = 800;
constexpr float EPS = 1e-6f, LOG2E = 1.4426950408889634f;
constexpr float ALPHA = 1.4142135623730951f;
constexpr int SMEM_BYTES = 75264;
constexpr int NPHASE = 14;

struct Params {
  const float *x, *c, *ctx, *c_ctx, *w_mod, *b_mod, *w_in, *relb, *qn, *wuq, *kvn, *wukv, *cw, *cb, *wa, *ba, *wx, *bx, *lam, *gqn, *gkn, *wbr, *wout, *lng, *lnb;
  float* out;
  u16 *xn, *Pk, *Pt, *VtAD, *QB, *KB, *VtB, *QD, *KD, *G;
  u16 *WtIn, *WtM, *WtUq, *WtUkv, *WtA, *WtX, *WtBr, *WtOut;
  float *mod, *agg, *ctxV, *ropeB, *ropeD;
  char* sgbuf;
  unsigned* bar;
};

typedef __bf16 bf16v2 __attribute__((ext_vector_type(2)));
typedef float f32v2 __attribute__((ext_vector_type(2)));
DI unsigned pack2(float a, float b) { f32v2 v = {a, b}; return __builtin_bit_cast(unsigned, __builtin_convertvector(v, bf16v2)); }
DI u16 f2bf(float x) { return (u16)(pack2(x, 0.f) & 0xffffu); }
DI float bf2f(u16 v) { return __uint_as_float(((unsigned)v) << 16); }
DI float bflo(unsigned v) { return __uint_as_float(v << 16); }
DI float bfhi(unsigned v) { return __uint_as_float(v & 0xffff0000u); }
DI float sigm(float x) { return __builtin_amdgcn_rcpf(1.f + __expf(-x)); }
DI float silu(float x) { return x * sigm(x); }
DI float sigm_fast(float x) { return __builtin_amdgcn_rcpf(1.f + __expf(-x)); }
DI float wave_sum(float v) { for (int o = 32; o > 0; o >>= 1) v += __shfl_xor(v, o); return v; }
DI float xhalf_max(float v) { auto r = __builtin_amdgcn_permlane32_swap(__float_as_uint(v), __float_as_uint(v), false, false); return fmaxf(__uint_as_float(r[0]), __uint_as_float(r[1])); }
DI float xhalf_sum(float v) { auto r = __builtin_amdgcn_permlane32_swap(__float_as_uint(v), __float_as_uint(v), false, false); return __uint_as_float(r[0]) + __uint_as_float(r[1]); }
DI int crow(int i, int h) { return (i & 3) + 8 * (i >> 2) + 4 * h; }
DI int clampi(int v, int lo, int hi) { return v < lo ? lo : (v > hi ? hi : v); }

struct GemmLds { u16 a[2][128][72]; u16 b[2][128][72]; };

template <int MB, bool PF2 = true>
DI void gemm_main(const u16* __restrict__ A, int lda, const u16* __restrict__ B, int ldb, int K, f32x16 (&acc)[MB][2], GemmLds* s, int tid) {
  const int lane = tid & 63, w = tid >> 6, r = lane & 31, h = lane >> 5, wm = w >> 1, wn = w & 1;
  const int srow = tid >> 3, skc = (tid & 7) * 8;
  const unsigned oa0 = (unsigned)(srow * lda + skc) * 2u, oa1 = oa0 + 64u * lda, oa2 = oa0 + 128u * lda, oa3 = oa0 + 192u * lda;
  const unsigned ob0 = (unsigned)(srow * ldb + skc) * 2u, ob1 = ob0 + 64u * ldb, ob2 = ob0 + 128u * ldb, ob3 = ob0 + 192u * ldb;
  uint4 pa0, pa1, pa2, pa3, pb0, pb1, pb2, pb3, qa0, qa1, qa2, qa3, qb0, qb1, qb2, qb3;
  pa2 = pa3 = qa2 = qa3 = make_uint4(0, 0, 0, 0);
#define G_LOAD(S, k0) { const char* ua_ = (const char*)(A + (k0)); const char* ub_ = (const char*)(B + (k0)); \
    S##a0 = *(const uint4*)(ua_ + oa0); S##a1 = *(const uint4*)(ua_ + oa1); \
    if (MB == 2) { S##a2 = *(const uint4*)(ua_ + oa2); S##a3 = *(const uint4*)(ua_ + oa3); } \
    S##b0 = *(const uint4*)(ub_ + ob0); S##b1 = *(const uint4*)(ub_ + ob1); S##b2 = *(const uint4*)(ub_ + ob2); S##b3 = *(const uint4*)(ub_ + ob3); }
#define G_STORE(S, bf) { *(uint4*)&s->a[bf][srow][skc] = S##a0; *(uint4*)&s->a[bf][srow + 32][skc] = S##a1; \
    if (MB == 2) { *(uint4*)&s->a[bf][srow + 64][skc] = S##a2; *(uint4*)&s->a[bf][srow + 96][skc] = S##a3; } \
    *(uint4*)&s->b[bf][srow][skc] = S##b0; *(uint4*)&s->b[bf][srow + 32][skc] = S##b1; *(uint4*)&s->b[bf][srow + 64][skc] = S##b2; *(uint4*)&s->b[bf][srow + 96][skc] = S##b3; }
#define G_COMPUTE(bf) { _Pragma("unroll") for (int ks = 0; ks < 4; ks++) { \
      bf16x8 af[MB], bfr[2]; \
      _Pragma("unroll") for (int mb = 0; mb < MB; mb++) af[mb] = *(const bf16x8*)&s->a[bf][wm * (32 * MB) + mb * 32 + r][ks * 16 + h * 8]; \
      _Pragma("unroll") for (int nb = 0; nb < 2; nb++) bfr[nb] = *(const bf16x8*)&s->b[bf][wn * 64 + nb * 32 + r][ks * 16 + h * 8]; \
      _Pragma("unroll") for (int mb = 0; mb < MB; mb++) _Pragma("unroll") for (int nb = 0; nb < 2; nb++) acc[mb][nb] = MFMA(af[mb], bfr[nb], acc[mb][nb]); } }
  int KT = K >> 6;
  asm volatile("" : "+s"(KT));
  __syncthreads();
  G_LOAD(p, 0); G_STORE(p, 0);
  if (!PF2) {
    __syncthreads();
    for (int kt = 0; kt < KT; kt++) {
      const int buf = kt & 1;
      if (kt + 1 < KT) G_LOAD(p, (kt + 1) * 64);
      if (buf) { G_COMPUTE(1); } else { G_COMPUTE(0); }
      if (kt + 1 < KT) { if (buf) { G_STORE(p, 0); } else { G_STORE(p, 1); } }
      __syncthreads();
    }
    return;
  }
  const int klast = K - 64;
  G_LOAD(p, 64);
  __syncthreads();
  for (int kt = 0; kt < KT; kt += 2) {
    { const int k2 = min((kt + 2) * 64, klast); G_LOAD(q, k2); }
    __builtin_amdgcn_sched_barrier(0);
    G_COMPUTE(0);
    G_STORE(p, 1);
    __syncthreads();
    { const int k3 = min((kt + 3) * 64, klast); G_LOAD(p, k3); }
    __builtin_amdgcn_sched_barrier(0);
    G_COMPUTE(1);
    G_STORE(q, 0);
    __syncthreads();
  }
#undef G_LOAD
#undef G_STORE
#undef G_COMPUTE
}

template <int MB>
DI void zero_acc(f32x16 (&acc)[MB][2]) {
#pragma unroll
  for (int a = 0; a < MB; a++)
#pragma unroll
    for (int b = 0; b < 2; b++)
#pragma unroll
      for (int i = 0; i < 16; i++) acc[a][b][i] = 0.f;
}

DI void row_rs(const u16* A, int lda, int K, float* rs, int tid) {
  const int row = tid >> 1, half = tid & 1, len = K >> 1;
  const u16* p = A + (size_t)row * lda + half * len;
  float ss = 0.f;
  for (int j = 0; j < len; j += 8) {
    uint4 v = *(const uint4*)(p + j);
    float a0 = bflo(v.x), a1 = bfhi(v.x), a2 = bflo(v.y), a3 = bfhi(v.y), a4 = bflo(v.z), a5 = bfhi(v.z), a6 = bflo(v.w), a7 = bfhi(v.w);
    ss += a0 * a0 + a1 * a1 + a2 * a2 + a3 * a3 + a4 * a4 + a5 * a5 + a6 * a6 + a7 * a7;
  }
  ss += __shfl_xor(ss, 1);
  if (half == 0) rs[row] = rsqrtf(ss / (float)K + EPS);
}

DI void sincos_red(float x, float& sn, float& cs) {
  const float k = rintf(x * 0.15915494309189535f);
  float y = fmaf(-k, 6.2831854820251465f, x);
  y = fmaf(-k, -1.7484555e-7f, y);
  sn = __sinf(y); cs = __cosf(y);
}

DI int win_srccol(int n) {
  if (n < 512) return n;
  if (n < 768) return 1184 + (n - 512);
  if (n < 1792) return 1952 + (n - 768);
  if (n < 2048) return 768 + (n - 1792);
  if (n < 2176) return 1024 + (n - 2048);
  if (n < 2208) return 1152 + (n - 2176);
  if (n < 2464) return 1440 + (n - 2208);
  if (n < 2592) return 1696 + (n - 2464);
  if (n < 2848) return 512 + (n - 2592);
  if (n < 2976) return 1824 + (n - 2848);
  return -1;
}

DI void convT_item(const float* __restrict__ src, int ld, int K, int kq, int n0, int mode, int coloff, const float* __restrict__ scale, u16* __restrict__ dst, int tid) {
  const int lane = tid & 63, wv = tid >> 6;
  const int n = n0 + lane;
  const int sc = (mode == 1) ? win_srccol(n) : (coloff + n);
#pragma unroll 4
  for (int j = 0; j < 8; j++) {
    const int k0 = kq * 256 + (wv + 4 * j) * 8;
    if (k0 >= K) break;
    float v[8];
#pragma unroll
    for (int e = 0; e < 8; e++) {
      float t = (sc >= 0) ? src[(size_t)(k0 + e) * ld + sc] : 0.f;
      if (scale) t *= scale[k0 + e];
      v[e] = t;
    }
    uint4 o; o.x = pack2(v[0], v[1]); o.y = pack2(v[2], v[3]); o.z = pack2(v[4], v[5]); o.w = pack2(v[6], v[7]);
    *(uint4*)(dst + (size_t)n * K + k0) = o;
  }
}

DI void mod_item(const Params& p, int it, char* smem, int tid) {
  const int l = it / 96, cg0 = (it % 96) * 32;
  float* s = (float*)smem;
  float* red = s + 9 * 1024;
  __syncthreads();
  for (int i = tid; i < 9 * 1024; i += 256) { int j = i >> 10, k = i & 1023; float v = (j < 8) ? p.c[j * 1024 + k] : p.c_ctx[k]; s[i] = silu(v); }
  __syncthreads();
  const int kg = tid >> 5, cl = tid & 31;
  float acc[9];
#pragma unroll
  for (int j = 0; j < 9; j++) acc[j] = 0.f;
  const float* wp = p.w_mod + (size_t)l * 1024 * 3072 + cg0 + cl;
#pragma unroll 16
  for (int k = kg * 128; k < kg * 128 + 128; k++) {
    float wv = wp[(size_t)k * 3072];
#pragma unroll
    for (int j = 0; j < 9; j++) acc[j] += s[j * 1024 + k] * wv;
  }
#pragma unroll
  for (int j = 0; j < 9; j++) red[(kg * 9 + j) * 32 + cl] = acc[j];
  __syncthreads();
  for (int i = tid; i < 288; i += 256) {
    int j = i >> 5, c2 = i & 31; float t = 0.f;
    for (int g = 0; g < 8; g++) t += red[(g * 9 + j) * 32 + c2];
    p.mod[((size_t)l * 9 + j) * 3072 + cg0 + c2] = t + p.b_mod[l * 3072 + cg0 + c2];
  }
}

DI void phase0(const Params& p, char* smem, int tid) {
  const int NCONV = 606;
  const int total = 193 + 2 * NCONV;
  for (int it = blockIdx.x; it < total; it += gridDim.x) {
    if (it < 192) { mod_item(p, it, smem, tid); continue; }
    if (it == 192) {
      for (int i = tid; i < 64 * 16; i += 256) { int pos = i >> 4, f = i & 15; float inv = exp2f(-(float)f * (13.287712379549449f / 16.f)); float sn, cs; sincos_red((float)pos * inv, sn, cs); p.ropeD[2 * i] = cs; p.ropeD[2 * i + 1] = sn; }
      for (int i = tid; i < 64 * 8; i += 256) { int pos = i >> 3, f = i & 7; float inv = exp2f(-(float)f * (13.287712379549449f / 8.f)); float sn, cs; sincos_red((float)pos * inv, sn, cs); p.ropeB[2 * i] = cs; p.ropeB[2 * i + 1] = sn; }
      continue;
    }
    int j = it - 193; const int l = j / NCONV; j -= l * NCONV;
    if (j < 192) { convT_item(p.w_in + (size_t)l * 1024 * NIN, NIN, 1024, j & 3, (j >> 2) * 64, 1, 0, nullptr, p.WtIn + (size_t)l * 3072 * 1024, tid); }
    else if (j < 448) { int jj = j - 192; convT_item(p.w_in + (size_t)l * 1024 * NIN, NIN, 1024, jj & 3, (jj >> 2) * 64, 0, 2976, nullptr, p.WtM + (size_t)l * 4096 * 1024, tid); }
    else if (j < 454) { int nt = j - 448; convT_item(p.wuq + (size_t)l * 256 * 384, 384, 256, 0, nt * 64, 0, 0, p.qn + l * 256, p.WtUq + (size_t)l * 384 * 256, tid); }
    else if (j < 462) { int nt = j - 454; convT_item(p.wukv + (size_t)l * 128 * 512, 512, 128, 0, nt * 64, 0, 0, p.kvn + l * 128, p.WtUkv + (size_t)l * 512 * 128, tid); }
    else if (j < 470) { int m = j - 462; convT_item(p.wa + ((size_t)l * 8 + m) * 4096, 64, 64, 0, 0, 0, 0, nullptr, p.WtA + ((size_t)l * 8 + m) * 4096, tid); }
    else if (j < 478) { int m = j - 470; convT_item(p.wx + ((size_t)l * 8 + m) * 4096, 64, 64, 0, 0, 0, 0, nullptr, p.WtX + ((size_t)l * 8 + m) * 4096, tid); }
    else if (j < 542) { int jj = j - 478; int i = jj >> 4, nt = jj & 15; convT_item(p.wbr + ((size_t)l * 4 + i) * 256 * 1024, 1024, 256, 0, nt * 64, 0, 0, nullptr, p.WtBr + ((size_t)l * 4 + i) * 1024 * 256, tid); }
    else { int jj = j - 542; convT_item(p.wout + (size_t)l * 1024 * 1024, 1024, 1024, jj & 3, (jj >> 2) * 64, 0, 0, nullptr, p.WtOut + (size_t)l * 1024 * 1024, tid); }
  }
}

DI void ln_stats(const float4 (&v)[4], float& mean, float& rstd) {
  float s = 0.f;
#pragma unroll
  for (int j = 0; j < 4; j++) s += v[j].x + v[j].y + v[j].z + v[j].w;
  mean = wave_sum(s) * (1.f / 1024.f);
  float q = 0.f;
#pragma unroll
  for (int j = 0; j < 4; j++) { float a = v[j].x - mean, b = v[j].y - mean, c2 = v[j].z - mean, d = v[j].w - mean; q += a * a + b * b + c2 * c2 + d * d; }
  rstd = rsqrtf(wave_sum(q) * (1.f / 1024.f) + EPS);
}

DI void write_xn(const Params& p, int l, int row, int jm, const float4 (&v)[4], float mean, float rstd, int lane) {
  const float* md = p.mod + ((size_t)l * 9 + jm) * 3072;
#pragma unroll
  for (int j = 0; j < 4; j++) {
    const int col = 4 * (lane + 64 * j);
    float4 sh = *(const float4*)(md + col), scl = *(const float4*)(md + 1024 + col);
    float a = (v[j].x - mean) * rstd * (1.f + scl.x) + sh.x, b = (v[j].y - mean) * rstd * (1.f + scl.y) + sh.y;
    float c2 = (v[j].z - mean) * rstd * (1.f + scl.z) + sh.z, d = (v[j].w - mean) * rstd * (1.f + scl.w) + sh.w;
    uint2 o; o.x = pack2(a, b); o.y = pack2(c2, d);
    *(uint2*)(p.xn + (size_t)row * 1024 + col) = o;
  }
}

DI const float* ln0_src(const Params& p, int row) {
  const int b = row / SEQA, pos = row % SEQA;
  return (pos < CTXL) ? p.ctx + ((size_t)b * CTXL + pos) * 1024 : p.x + ((size_t)b * SEQ + pos - CTXL) * 1024;
}
DI void phase_ln0(const Params& p, int tid) {
  const int lane = tid & 63, w = tid >> 6;
  const int stride = gridDim.x * 4;
  int row = blockIdx.x * 4 + w;
  float4 v[4], nv[4];
  if (row < R) { const float* src = ln0_src(p, row);
#pragma unroll
    for (int j = 0; j < 4; j++) v[j] = *(const float4*)(src + 4 * (lane + 64 * j)); }
  while (row < R) {
    const int nrow = row + stride;
    if (nrow < R) { const float* nsrc = ln0_src(p, nrow);
#pragma unroll
      for (int j = 0; j < 4; j++) nv[j] = *(const float4*)(nsrc + 4 * (lane + 64 * j)); }
    __builtin_amdgcn_sched_barrier(0);
    const int b = row / SEQA, pos = row % SEQA;
    float mean, rstd; ln_stats(v, mean, rstd);
    write_xn(p, 0, row, pos < CTXL ? 8 : b, v, mean, rstd, lane);
#pragma unroll
    for (int j = 0; j < 4; j++) v[j] = nv[j];
    row = nrow;
  }
}

DI const float* lnf_res(const Params& p, int l, int row) {
  const int b = row / SEQA, pos = row % SEQA;
  if (pos < CTXL) return p.ctx + ((size_t)b * CTXL + pos) * 1024;
  return (l == 0 ? p.x : (const float*)p.out) + ((size_t)b * SEQ + pos - CTXL) * 1024;
}
DI void phase_lnf(const Params& p, int l, int tid) {
  const int lane = tid & 63, w = tid >> 6;
  const int stride = gridDim.x * 4;
  int row = blockIdx.x * 4 + w;
  float4 v[4], nv[4]; uint2 ov[4], nov[4];
  if (row < R) { const float* src = lnf_res(p, l, row); const u16* os = p.G + (size_t)row * 1024;
#pragma unroll
    for (int j = 0; j < 4; j++) { v[j] = *(const float4*)(src + 4 * (lane + 64 * j)); ov[j] = *(const uint2*)(os + 4 * (lane + 64 * j)); } }
  while (row < R) {
    const int nrow = row + stride;
    if (nrow < R) { const float* nsrc = lnf_res(p, l, nrow); const u16* nos = p.G + (size_t)nrow * 1024;
#pragma unroll
      for (int j = 0; j < 4; j++) { nv[j] = *(const float4*)(nsrc + 4 * (lane + 64 * j)); nov[j] = *(const uint2*)(nos + 4 * (lane + 64 * j)); } }
    __builtin_amdgcn_sched_barrier(0);
    const int b = row / SEQA, pos = row % SEQA;
    if (!(l == 1 && pos < CTXL)) {
      float* dst = (pos < CTXL) ? p.ctxV + ((size_t)b * CTXL + pos) * 1024 : p.out + ((size_t)b * SEQ + pos - CTXL) * 1024;
#pragma unroll
      for (int j = 0; j < 4; j++) {
        v[j].x = ALPHA * v[j].x + bflo(ov[j].x); v[j].y = ALPHA * v[j].y + bfhi(ov[j].x);
        v[j].z = ALPHA * v[j].z + bflo(ov[j].y); v[j].w = ALPHA * v[j].w + bfhi(ov[j].y);
      }
      float mean, rstd; ln_stats(v, mean, rstd);
#pragma unroll
      for (int j = 0; j < 4; j++) {
        const int col = 4 * (lane + 64 * j);
        float4 g = *(const float4*)(p.lng + l * 1024 + col), bb = *(const float4*)(p.lnb + l * 1024 + col);
        v[j].x = (v[j].x - mean) * rstd * g.x + bb.x; v[j].y = (v[j].y - mean) * rstd * g.y + bb.y;
        v[j].z = (v[j].z - mean) * rstd * g.z + bb.z; v[j].w = (v[j].w - mean) * rstd * g.w + bb.w;
        if (pos >= CTXL) *(float4*)(dst + col) = v[j];
      }
      if (l == 0) { ln_stats(v, mean, rstd); write_xn(p, 1, row, pos < CTXL ? 8 : b, v, mean, rstd, lane); }
    }
#pragma unroll
    for (int j = 0; j < 4; j++) { v[j] = nv[j]; ov[j] = nov[j]; }
    row = nrow;
  }
}

DI void vt_store32(const float (&v)[2][16], u16* T, u16* g, int lane) {
  const int r = lane & 31, h = lane >> 5;
#pragma unroll
  for (int mb = 0; mb < 2; mb++)
#pragma unroll
    for (int g4 = 0; g4 < 4; g4++) {
      uint2 o; o.x = pack2(v[mb][4 * g4], v[mb][4 * g4 + 1]); o.y = pack2(v[mb][4 * g4 + 2], v[mb][4 * g4 + 3]);
      *(uint2*)(T + r * 72 + mb * 32 + 8 * g4 + 4 * h) = o;
    }
  asm volatile("" ::: "memory");
#pragma unroll
  for (int j = 0; j < 4; j++) {
    const int cc = (lane >> 3) + 8 * j, tc = lane & 7;
    const uint4 x = *(const uint4*)(T + cc * 72 + tc * 8);
    *(uint4*)(g + (size_t)cc * SEQA + tc * 8) = x;
  }
  asm volatile("" ::: "memory");
}

DI void phase_inproj(const Params& p, int l, char* smem, int tid) {
  const int lane = tid & 63, w = tid >> 6, r = lane & 31, h = lane >> 5, wm = w >> 1, wn = w & 1;
  GemmLds* s = (GemmLds*)smem;
  const u16* Wt = p.WtIn + (size_t)l * 3072 * 1024;
  for (int it = blockIdx.x; it < 272 * 24; it += gridDim.x) {
    const int mt = it / 24, nt = it % 24, m0 = mt * 128, n0 = nt * 128;
    f32x16 acc[2][2]; zero_acc<2>(acc);
    gemm_main<2>(p.xn + (size_t)m0 * 1024, 1024, Wt + (size_t)n0 * 1024, 1024, 1024, acc, s, tid);
#pragma unroll
    for (int mb = 0; mb < 2; mb++)
#pragma unroll
      for (int nb = 0; nb < 2; nb++) {
        const int rowb = m0 + wm * 64 + mb * 32, colb = n0 + wn * 64 + nb * 32, col = colb + r;
        if (colb < 1792) {
          const float qs = (colb < 256) ? 0.125f * LOG2E : 1.f;
#pragma unroll
          for (int i = 0; i < 16; i++) p.Pk[(size_t)(rowb + crow(i, h)) * PKW + col] = f2bf(acc[mb][nb][i] * qs);
        } else if (colb < 2592) {
#pragma unroll
          for (int i = 0; i < 16; i++) p.Pt[(size_t)(rowb + crow(i, h)) * PTW + col - 1792] = f2bf(acc[mb][nb][i]);
        }
      }
#pragma unroll
    for (int nb = 0; nb < 2; nb++) {
      const int colb = n0 + wn * 64 + nb * 32;
      if (colb >= 2592 && colb < 2976) {
        const int rw = m0 + wm * 64;
        float v[2][16];
#pragma unroll
        for (int mb = 0; mb < 2; mb++)
#pragma unroll
          for (int i = 0; i < 16; i++) v[mb][i] = acc[mb][nb][i];
        vt_store32(v, (u16*)smem + w * (32 * 72), p.VtAD + ((size_t)(rw / SEQA) * 384 + colb - 2592) * SEQA + rw % SEQA, lane);
      }
    }
  }
}

DI void lru_item(const Params& p, int l, int b, int chunk, int blk, bool fin, char* smem, int tid) {
  const int lane = tid & 63, w = tid >> 6, r = lane & 31, h = lane >> 5;
  u16 (*xcb)[72] = (u16(*)[72])smem;
  float2* au = (float2*)(smem + 9216);
  u16* xr = (u16*)(smem + 9216);
  const int pos0 = chunk * 64, c0 = blk * 64;
  const int segLo = (chunk < 4) ? 0 : CTXL, segHi = (chunk < 4) ? CTXL : SEQA;
  __syncthreads();
  for (int cidx = tid; cidx < 68 * 8; cidx += 256) {
    const int t = cidx >> 3, kc = cidx & 7, pos = pos0 + t - 2;
    uint4 v = make_uint4(0, 0, 0, 0);
    if (pos >= segLo && pos < segHi) v = *(const uint4*)(p.Pk + ((size_t)b * SEQA + pos) * PKW + 512 + c0 + kc * 8);
    *(uint4*)(xr + t * 64 + kc * 8) = v;
  }
  __syncthreads();
  {
    const int ch = tid & 63;
    const float* cw = p.cw + (size_t)l * 4 * 256 + c0 + ch;
    const float w0 = cw[0], w1 = cw[256], w2 = cw[512], w3 = cw[768], bias = p.cb[l * 256 + c0 + ch];
#pragma unroll 4
    for (int e = 0; e < 16; e++) {
      const int t = (tid >> 6) + 4 * e;
      float v = w0 * bf2f(xr[t * 64 + ch]) + w1 * bf2f(xr[(t + 1) * 64 + ch]) + w2 * bf2f(xr[(t + 2) * 64 + ch]) + w3 * bf2f(xr[(t + 3) * 64 + ch]) + bias;
      xcb[t][ch] = f2bf(v);
    }
  }
  __syncthreads();
  {
    const int tb = w & 1, ob = w >> 1;
    const int chn = ob * 32 + r;
#pragma unroll
    for (int dir = 0; dir < 2; dir++) {
      f32x16 ga, gx;
#pragma unroll
      for (int i = 0; i < 16; i++) { ga[i] = 0.f; gx[i] = 0.f; }
      const u16* wa = p.WtA + (((size_t)l * 2 + dir) * 4 + blk) * 4096 + (size_t)chn * 64 + h * 8;
      const u16* wx = p.WtX + (((size_t)l * 2 + dir) * 4 + blk) * 4096 + (size_t)chn * 64 + h * 8;
#pragma unroll
      for (int ks = 0; ks < 4; ks++) {
        bf16x8 a = *(const bf16x8*)&xcb[tb * 32 + r][ks * 16 + h * 8];
        bf16x8 ba = *(const bf16x8*)(wa + ks * 16), bx = *(const bf16x8*)(wx + ks * 16);
        ga = MFMA(a, ba, ga); gx = MFMA(a, bx, gx);
      }
      const int pi = (l * 2 + dir) * 256 + c0 + chn;
      const float b_a = p.ba[pi], b_x = p.bx[pi], lam = p.lam[pi];
      const float sp = log1pf(__expf(-lam));
#pragma unroll
      for (int i = 0; i < 16; i++) {
        const int tok = tb * 32 + crow(i, h);
        const float rr = __builtin_amdgcn_rcpf(1.f + __expf(-(ga[i] + b_a))), ii = __builtin_amdgcn_rcpf(1.f + __expf(-(gx[i] + b_x)));
        const float la = -8.f * rr * sp;
        const float a = __expf(la);
        const float x2 = 2.f * la;
        const float ser = -x2 * (1.f + x2 * (0.5f + x2 * (0.16666667f + x2 * (0.041666668f + x2 * 0.0083333338f))));
        const float om = (x2 > -0.25f) ? ser : (1.f - a * a);
        const float u = __builtin_amdgcn_sqrtf(fmaxf(om, 0.f)) * ii * bf2f(xcb[tok][chn]);
        au[(dir * 64 + tok) * 64 + chn] = make_float2(a, u);
      }
    }
  }
  __syncthreads();
  float2* agg = (float2*)p.agg;
  if (w < 2) {
    const int dir = w, ch = lane;
    float hst = 0.f;
    if (!fin) {
      float Ap = 1.f;
#pragma unroll 8
      for (int s2 = 0; s2 < 64; s2++) { const int t = dir ? 63 - s2 : s2; float2 v = au[(dir * 64 + t) * 64 + ch]; hst = v.x * hst + v.y; Ap *= v.x; }
      agg[(((size_t)b * 68 + chunk) * 2 + dir) * 256 + c0 + ch] = make_float2(Ap, hst);
    } else {
      const float2* ag = agg + ((size_t)b * 68 * 2 + dir) * 256 + c0 + ch;
      if (dir == 0) {
#pragma unroll 8
        for (int cc = 0; cc < chunk; cc++) { float2 v = ag[(size_t)cc * 512]; hst = v.x * hst + v.y; }
      } else {
        if (chunk < 4) { for (int cc = 3; cc > chunk; cc--) { float2 v = ag[(size_t)cc * 512]; hst = v.x * hst + v.y; } }
        else {
          for (int cc = 3; cc >= 0; cc--) { float2 v = ag[(size_t)cc * 512]; hst = v.x * hst + v.y; }
#pragma unroll 8
          for (int cc = 67; cc > chunk; cc--) { float2 v = ag[(size_t)cc * 512]; hst = v.x * hst + v.y; }
        }
      }
#pragma unroll 8
      for (int s2 = 0; s2 < 64; s2++) { const int t = dir ? 63 - s2 : s2; float2 v = au[(dir * 64 + t) * 64 + ch]; hst = v.x * hst + v.y; au[(dir * 64 + t) * 64 + ch].y = hst; }
    }
  }
  if (fin) {
    __syncthreads();
    const int ch4 = (tid & 15) * 4;
#pragma unroll
    for (int ps = 0; ps < 4; ps++) {
      const int t = (tid >> 4) + 16 * ps;
      const size_t row = (size_t)b * SEQA + pos0 + t;
      uint2 zz = *(const uint2*)(p.Pk + row * PKW + 768 + 512 + c0 + ch4);
      float y0 = au[(t) * 64 + ch4].y + au[(64 + t) * 64 + ch4].y, y1 = au[(t) * 64 + ch4 + 1].y + au[(64 + t) * 64 + ch4 + 1].y;
      float y2 = au[(t) * 64 + ch4 + 2].y + au[(64 + t) * 64 + ch4 + 2].y, y3 = au[(t) * 64 + ch4 + 3].y + au[(64 + t) * 64 + ch4 + 3].y;
      uint2 o; o.x = pack2(y0 * silu(bflo(zz.x)), y1 * silu(bfhi(zz.x))); o.y = pack2(y2 * silu(bflo(zz.y)), y3 * silu(bfhi(zz.y)));
      *(uint2*)(p.G + row * 1024 + 512 + c0 + ch4) = o;
    }
  }
}

DI void rope32(float (&y)[64], int base, const float* tab  , int pr) {
#pragma unroll
  for (int d = 0; d < 16; d++) {
    float2 cs = *(const float2*)(tab + (pr * 16 + d) * 2);
    float a = y[base + d], b = y[base + 16 + d];
    y[base + d] = a * cs.x - b * cs.y; y[base + 16 + d] = b * cs.x + a * cs.y;
  }
}

DI void gqa_head(const Params& p, int l, int row, const u16* src, const float* g, u16* dst, float mul) {
  const int pos = row % SEQA;
  float y[64];
  float ss = 0.f;
#pragma unroll
  for (int j = 0; j < 8; j++) {
    uint4 v = *(const uint4*)(src + j * 8);
    y[8 * j] = bflo(v.x); y[8 * j + 1] = bfhi(v.x); y[8 * j + 2] = bflo(v.y); y[8 * j + 3] = bfhi(v.y);
    y[8 * j + 4] = bflo(v.z); y[8 * j + 5] = bfhi(v.z); y[8 * j + 6] = bflo(v.w); y[8 * j + 7] = bfhi(v.w);
  }
#pragma unroll
  for (int d = 0; d < 64; d++) ss += y[d] * y[d];
  const float rinv = rsqrtf(ss * (1.f / 64.f) + EPS) * mul;
#pragma unroll
  for (int d = 0; d < 64; d++) y[d] = y[d] * rinv * g[d];
  if (pos >= CTXL) { const int t = pos - CTXL; rope32(y, 0, p.ropeD, t >> 6); rope32(y, 32, p.ropeD, t & 63); }
#pragma unroll
  for (int j = 0; j < 8; j++) {
    uint4 o; o.x = pack2(y[8 * j], y[8 * j + 1]); o.y = pack2(y[8 * j + 2], y[8 * j + 3]); o.z = pack2(y[8 * j + 4], y[8 * j + 5]); o.w = pack2(y[8 * j + 6], y[8 * j + 7]);
    *(uint4*)(dst + j * 8) = o;
  }
}

DI void prep_item(const Params& p, int l, int mt, int tid) {
  const int m0 = mt * 128;
  for (int e = tid; e < 512; e += 256) {
    const int row = m0 + (e >> 2), hd = e & 3;
    gqa_head(p, l, row, p.Pt + (size_t)row * PTW + 416 + hd * 64, p.gqn + l * 64, p.QD + (size_t)row * 256 + hd * 64, 0.125f * LOG2E);
  }
  {
    const int row = m0 + (tid >> 1), hk = tid & 1; const int b = row / SEQA, pos = row % SEQA;
    gqa_head(p, l, row, p.Pt + (size_t)row * PTW + 672 + hk * 64, p.gkn + l * 64, p.KD + (((size_t)b * 2 + hk) * SEQA + pos) * 64, 1.f);
  }
  if (tid < 128) {
    const int row = m0 + tid; const int b = row / SEQA, pos = row % SEQA;
    const u16* src = p.Pt + (size_t)row * PTW + 384;
    float y[32];
#pragma unroll
    for (int j = 0; j < 4; j++) {
      uint4 v = *(const uint4*)(src + j * 8);
      y[8 * j] = bflo(v.x); y[8 * j + 1] = bfhi(v.x); y[8 * j + 2] = bflo(v.y); y[8 * j + 3] = bfhi(v.y);
      y[8 * j + 4] = bflo(v.z); y[8 * j + 5] = bfhi(v.z); y[8 * j + 6] = bflo(v.w); y[8 * j + 7] = bfhi(v.w);
    }
    if (pos >= CTXL) {
      const int t = pos - CTXL;
#pragma unroll
      for (int hf = 0; hf < 2; hf++) {
        const int pr = hf ? (t & 63) : (t >> 6);
#pragma unroll
        for (int d = 0; d < 8; d++) {
          float2 cs = *(const float2*)(p.ropeB + (pr * 8 + d) * 2);
          float a = y[16 * hf + d], bq = y[16 * hf + 8 + d];
          y[16 * hf + d] = a * cs.x - bq * cs.y; y[16 * hf + 8 + d] = bq * cs.x + a * cs.y;
        }
      }
    }
#pragma unroll
    for (int hd = 0; hd < 4; hd++) {
      u16* dst = p.KB + (((size_t)b * 4 + hd) * SEQA + pos) * 96 + 64;
#pragma unroll
      for (int j = 0; j < 4; j++) {
        uint4 o; o.x = pack2(y[8 * j], y[8 * j + 1]); o.y = pack2(y[8 * j + 2], y[8 * j + 3]); o.z = pack2(y[8 * j + 4], y[8 * j + 5]); o.w = pack2(y[8 * j + 6], y[8 * j + 7]);
        *(uint4*)(dst + j * 8) = o;
      }
    }
  }
}

DI void phase_prep(const Params& p, int l, char* smem, int tid) {
  const int lane = tid & 63, w = tid >> 6, r = lane & 31, h = lane >> 5, wm = w >> 1, wn = w & 1;
  GemmLds* s = (GemmLds*)smem;
  float* rs = (float*)(smem + sizeof(GemmLds));
  const int NQ = 272 * 3, NKV = 272 * 4, NPR = 272, NLRU = 8 * 68 * 4;
  const int G = gridDim.x;
  int start = blockIdx.x;
  for (int it = start; it < NQ; it += G) {
      const int mt = it / 3, nt = it % 3, m0 = mt * 128, n0 = nt * 128;
      const u16* A = p.Pt + (size_t)m0 * PTW;
      __syncthreads();
      row_rs(A, PTW, 256, rs, tid);
      f32x16 acc[2][2]; zero_acc<2>(acc);
      gemm_main<2>(A, PTW, p.WtUq + (size_t)l * 384 * 256 + (size_t)n0 * 256, 256, 256, acc, s, tid);
#pragma unroll
      for (int mb = 0; mb < 2; mb++)
#pragma unroll
        for (int nb = 0; nb < 2; nb++) {
          const int rl = wm * 64 + mb * 32, rowb = m0 + rl, colb = n0 + wn * 64 + nb * 32, col = colb + r;
          const int pos0 = rowb % SEQA;
          const bool rope = ((colb >> 5) % 3 == 2) && (pos0 >= CTXL);
#pragma unroll
          for (int i = 0; i < 16; i++) {
            const int ro = crow(i, h);
            float v = acc[mb][nb][i] * rs[rl + ro];
            if (rope) {
              const float pv = __shfl_xor(v, 8);
              const int t = pos0 + ro - CTXL; const int pr = (r & 16) ? (t & 63) : (t >> 6);
              float2 cs = *(const float2*)(p.ropeB + (pr * 8 + (r & 7)) * 2);
              v = v * cs.x + ((r & 8) ? pv : -pv) * cs.y;
            }
            p.QB[(size_t)(rowb + ro) * 384 + col] = f2bf(v * (0.10206207261596577f * LOG2E));
          }
        }
  }
  start = (start + G - NQ % G) % G;
  for (int j = start; j < NKV; j += G) {
      const int mt = j >> 2, nt = j & 3, m0 = mt * 128, n0 = nt * 128;
      const u16* A = p.Pt + (size_t)m0 * PTW + 256;
      __syncthreads();
      row_rs(A, PTW, 128, rs, tid);
      f32x16 acc[2][2]; zero_acc<2>(acc);
      gemm_main<2>(A, PTW, p.WtUkv + (size_t)l * 512 * 128 + (size_t)n0 * 128, 128, 128, acc, s, tid);
#pragma unroll
      for (int mb = 0; mb < 2; mb++)
#pragma unroll
        for (int nb = 0; nb < 2; nb++) {
          const int rl = wm * 64 + mb * 32, rowb = m0 + rl, colb = n0 + wn * 64 + nb * 32, col = colb + r;
          const int b = rowb / SEQA, pos0 = rowb % SEQA, hd = col >> 7, wc = col & 127;
          if (wc < 64) {
            u16* dst = p.KB + (((size_t)b * 4 + hd) * SEQA + pos0) * 96 + wc;
#pragma unroll
            for (int i = 0; i < 16; i++) { const int ro = crow(i, h); dst[(size_t)ro * 96] = f2bf(acc[mb][nb][i] * rs[rl + ro]); }
          } else {
            u16* dst = p.VtB + (((size_t)b * 4 + hd) * 64 + (wc - 64)) * SEQA + pos0;
#pragma unroll
            for (int g = 0; g < 4; g++) {
              const int ro = 8 * g + 4 * h;
              uint2 o; o.x = pack2(acc[mb][nb][4 * g] * rs[rl + ro], acc[mb][nb][4 * g + 1] * rs[rl + ro + 1]);
              o.y = pack2(acc[mb][nb][4 * g + 2] * rs[rl + ro + 2], acc[mb][nb][4 * g + 3] * rs[rl + ro + 3]);
              *(uint2*)(dst + ro) = o;
            }
          }
        }
  }
  start = (start + G - NKV % G) % G;
  for (int j = start; j < NPR; j += G) prep_item(p, l, j, tid);
  start = (start + G - NPR % G) % G;
  for (int j = start; j < NLRU; j += G) {
      const int blk = j & 3, chunk = (j >> 2) % 68, b = (j >> 2) / 68;
      lru_item(p, l, b, chunk, blk, false, smem, tid);
  }
}

template <int DK, bool NA>
DI void attn_item(const u16* __restrict__ Q, int ldq, const u16* __restrict__ K, int ldk, const u16* __restrict__ Vt, int nTiles, float sc,
                  int nWin, int rsA, int pr, const float* __restrict__ relb_h, u16* __restrict__ Gp, const u16* __restrict__ Zp, char* smem, int tid) {
  constexpr int KS = DK / 16, LK = DK + 8, KCH = DK / 8, NKC = (64 * KCH) / 256;
  u16 (*Ks)[64][LK] = (u16(*)[64][LK])smem;
  u16 (*Vs)[64][72] = (u16(*)[64][72])(smem + 2 * 64 * LK * 2);
  float* biasL = (float*)(smem + 2 * 64 * LK * 2 + 2 * 64 * 72 * 2);
  const int lane = tid & 63, w = tid >> 6, r = lane & 31, h = lane >> 5;
  __syncthreads();
  if (NA) { for (int i = tid; i < 465; i += 256) biasL[i] = relb_h[i] * LOG2E; }
  bf16x8 qf[KS];
  {
    const u16* qrow = Q + (size_t)(w * 32 + r) * ldq + h * 8;
#pragma unroll
    for (int ks = 0; ks < KS; ks++) qf[ks] = *(const bf16x8*)(qrow + ks * 16);
  }
  const int iw = 2 * pr + (w >> 1), rsw = clampi(iw - 4, 0, 56), jq = 32 * (w & 1) + r, cs = clampi(jq - 8, 0, 48);
  f32x16 o[2];
#pragma unroll
  for (int i = 0; i < 16; i++) { o[0][i] = 0.f; o[1][i] = 0.f; }
  float m_run = -1e30f, l_run = 0.f;
  uint4 rk0, rk1, rk2, rv0, rv1;
  rk2 = make_uint4(0, 0, 0, 0);
  const int kr0 = tid / KCH, kc0 = (tid % KCH) * 8, kr1 = (tid + 256) / KCH, kc1 = ((tid + 256) % KCH) * 8, kr2 = (tid + 512) / KCH, kc2 = ((tid + 512) % KCH) * 8;
  const int vd0 = tid >> 3, vk0 = (tid & 7) * 8;
#define TILE_POS(t) (NA ? ((t) < nWin ? CTXL + (rsA + (t)) * 64 : ((t) - nWin) * 64) : (t) * 64)
#define GLOAD(t) { const int pos0_ = TILE_POS(t); \
    rk0 = *(const uint4*)(K + (size_t)(pos0_ + kr0) * ldk + kc0); rk1 = *(const uint4*)(K + (size_t)(pos0_ + kr1) * ldk + kc1); \
    if (NKC == 3) rk2 = *(const uint4*)(K + (size_t)(pos0_ + kr2) * ldk + kc2); \
    rv0 = *(const uint4*)(Vt + (size_t)vd0 * SEQA + pos0_ + vk0); rv1 = *(const uint4*)(Vt + (size_t)(vd0 + 32) * SEQA + pos0_ + vk0); }
#define LSTORE(bf) { *(uint4*)&Ks[bf][kr0][kc0] = rk0; *(uint4*)&Ks[bf][kr1][kc1] = rk1; if (NKC == 3) *(uint4*)&Ks[bf][kr2][kc2] = rk2; \
    *(uint4*)&Vs[bf][vd0][vk0] = rv0; *(uint4*)&Vs[bf][vd0 + 32][vk0] = rv1; }
  GLOAD(0); LSTORE(0);
  __syncthreads();
  for (int t = 0; t < nTiles; t++) {
    const int buf = t & 1;
    if (t + 1 < nTiles) GLOAD(t + 1);
    const bool win = NA && (t < nWin);
    const int kr = rsA + t;
    bool act = true;
    if (win) act = (kr >= rsw) && (kr < rsw + 8);
    if (act) {
      f32x16 s[2];
      __builtin_amdgcn_s_setprio(1);
#pragma unroll
      for (int kb = 0; kb < 2; kb++) {
#pragma unroll
        for (int i = 0; i < 16; i++) s[kb][i] = 0.f;
#pragma unroll
        for (int ks = 0; ks < KS; ks++) { bf16x8 a = *(const bf16x8*)&Ks[buf][kb * 32 + r][ks * 16 + h * 8]; s[kb] = MFMA(a, qf[ks], s[kb]); }
      }
      __builtin_amdgcn_s_setprio(0);
      float mx = -1e30f;
#pragma unroll
      for (int kb = 0; kb < 2; kb++)
#pragma unroll
        for (int i = 0; i < 16; i++) {
          float v = s[kb][i];
          if (NA) {
            if (win) {
              const int kc = kb * 32 + (i & 3) + 8 * (i >> 2) + 4 * h;
              const bool vis = (unsigned)(kc - cs) < 16u;
              const int idx = (kr - iw + 7) * 31 + (kc - jq + 15);
              const float bv = biasL[vis ? idx : 0];
              v = vis ? v + bv : -1e30f;
            }
          }
          s[kb][i] = v; mx = fmaxf(mx, v);
        }
      mx = xhalf_max(mx);
      float mn = m_run;
      if (__builtin_amdgcn_ballot_w64(mx > m_run) != 0) {
        mn = fmaxf(m_run, mx);
        const float al = __builtin_amdgcn_exp2f(m_run - mn);
        m_run = mn; l_run *= al;
#pragma unroll
        for (int i = 0; i < 16; i++) { o[0][i] *= al; o[1][i] *= al; }
      }
      float ls = 0.f;
#pragma unroll
      for (int kb = 0; kb < 2; kb++)
#pragma unroll
        for (int i = 0; i < 16; i++) { float pv = __builtin_amdgcn_exp2f(s[kb][i] - mn); s[kb][i] = pv; ls += pv; }
      l_run += ls;
      bf16x8 pf[2][2];
#pragma unroll
      for (int kb = 0; kb < 2; kb++)
#pragma unroll
        for (int sx = 0; sx < 2; sx++) {
          uint4 u; u.x = pack2(s[kb][8 * sx], s[kb][8 * sx + 1]); u.y = pack2(s[kb][8 * sx + 2], s[kb][8 * sx + 3]);
          u.z = pack2(s[kb][8 * sx + 4], s[kb][8 * sx + 5]); u.w = pack2(s[kb][8 * sx + 6], s[kb][8 * sx + 7]);
          pf[kb][sx] = __builtin_bit_cast(bf16x8, u);
        }
      __builtin_amdgcn_s_setprio(1);
#pragma unroll
      for (int db = 0; db < 2; db++)
#pragma unroll
        for (int kb = 0; kb < 2; kb++)
#pragma unroll
          for (int sx = 0; sx < 2; sx++) {
            const u16* vp = &Vs[buf][db * 32 + r][32 * kb + 16 * sx + 4 * h];
            uint2 lo = *(const uint2*)vp, hi = *(const uint2*)(vp + 8);
            uint4 u; u.x = lo.x; u.y = lo.y; u.z = hi.x; u.w = hi.y;
            o[db] = MFMA(__builtin_bit_cast(bf16x8, u), pf[kb][sx], o[db]);
          }
      __builtin_amdgcn_s_setprio(0);
    }
    if (t + 1 < nTiles) LSTORE(buf ^ 1);
    __syncthreads();
  }
#undef TILE_POS
#undef GLOAD
#undef LSTORE
  const float lt = xhalf_sum(l_run);
  const float inv = __builtin_amdgcn_rcpf(lt);
  const int q = w * 32 + r;
#pragma unroll
  for (int db = 0; db < 2; db++)
#pragma unroll
    for (int g = 0; g < 4; g++) {
      const int d0 = 32 * db + 8 * g + 4 * h;
      uint2 zz = *(const uint2*)(Zp + (size_t)q * PKW + d0);
      uint2 ov; ov.x = pack2(o[db][4 * g] * inv * silu(bflo(zz.x)), o[db][4 * g + 1] * inv * silu(bfhi(zz.x)));
      ov.y = pack2(o[db][4 * g + 2] * inv * silu(bflo(zz.y)), o[db][4 * g + 3] * inv * silu(bfhi(zz.y)));
      *(uint2*)(Gp + (size_t)q * 1024 + d0) = ov;
    }
}

template <int DK>
DI void attn_item2(const u16* __restrict__ Q, int ldq, const u16* __restrict__ K, int ldk, const u16* __restrict__ Vt, int nTiles,
                   u16* __restrict__ Gp, const u16* __restrict__ Zp, char* smem, int tid) {
  constexpr int KS = DK / 16, LK = DK + 8, KCH = DK / 8, NKC = (64 * KCH) / 256;
  u16 (*Ks)[64][LK] = (u16(*)[64][LK])smem;
  u16 (*Vs)[64][72] = (u16(*)[64][72])(smem + 2 * 64 * LK * 2);
  const int lane = tid & 63, w = tid >> 6, r = lane & 31, h = lane >> 5;
  __syncthreads();
  bf16x8 qf[2][KS];
#pragma unroll
  for (int qw = 0; qw < 2; qw++) {
    const u16* qrow = Q + (size_t)((w * 2 + qw) * 32 + r) * ldq + h * 8;
#pragma unroll
    for (int ks = 0; ks < KS; ks++) qf[qw][ks] = *(const bf16x8*)(qrow + ks * 16);
  }
  f32x16 o[2][2];
#pragma unroll
  for (int i = 0; i < 16; i++) { o[0][0][i] = 0.f; o[0][1][i] = 0.f; o[1][0][i] = 0.f; o[1][1][i] = 0.f; }
  float m_run0 = -1e30f, m_run1 = -1e30f, l_run0 = 0.f, l_run1 = 0.f;
  uint4 rk0, rk1, rk2, rv0, rv1;
  rk2 = make_uint4(0, 0, 0, 0);
  const int kr0 = tid / KCH, kc0 = (tid % KCH) * 8, kr1 = (tid + 256) / KCH, kc1 = ((tid + 256) % KCH) * 8, kr2 = (tid + 512) / KCH, kc2 = ((tid + 512) % KCH) * 8;
  const int vd0 = tid >> 3, vk0 = (tid & 7) * 8;
#define GLOAD(t) { const int pos0_ = (t) * 64; \
    rk0 = *(const uint4*)(K + (size_t)(pos0_ + kr0) * ldk + kc0); rk1 = *(const uint4*)(K + (size_t)(pos0_ + kr1) * ldk + kc1); \
    if (NKC == 3) rk2 = *(const uint4*)(K + (size_t)(pos0_ + kr2) * ldk + kc2); \
    rv0 = *(const uint4*)(Vt + (size_t)vd0 * SEQA + pos0_ + vk0); rv1 = *(const uint4*)(Vt + (size_t)(vd0 + 32) * SEQA + pos0_ + vk0); }
#define LSTORE(bf) { *(uint4*)&Ks[bf][kr0][kc0] = rk0; *(uint4*)&Ks[bf][kr1][kc1] = rk1; if (NKC == 3) *(uint4*)&Ks[bf][kr2][kc2] = rk2; \
    *(uint4*)&Vs[bf][vd0][vk0] = rv0; *(uint4*)&Vs[bf][vd0 + 32][vk0] = rv1; }
  GLOAD(0); LSTORE(0);
  __syncthreads();
  for (int t = 0; t < nTiles; t++) {
    const int buf = t & 1;
    if (t + 1 < nTiles) GLOAD(t + 1);
#pragma unroll
    for (int kb = 0; kb < 2; kb++) {
      f32x16 s0, s1;
#pragma unroll
      for (int i = 0; i < 16; i++) { s0[i] = 0.f; s1[i] = 0.f; }
      __builtin_amdgcn_s_setprio(1);
#pragma unroll
      for (int ks = 0; ks < KS; ks++) {
        bf16x8 a = *(const bf16x8*)&Ks[buf][kb * 32 + r][ks * 16 + h * 8];
        s0 = MFMA(a, qf[0][ks], s0);
        s1 = MFMA(a, qf[1][ks], s1);
      }
      __builtin_amdgcn_s_setprio(0);
      bf16x8 pf0[2], pf1[2];
#define SOFTMAX_STEP(S, M, L, O, PF) { \
        float mx = fmaxf(fmaxf(fmaxf(S[0], S[1]), fmaxf(S[2], S[3])), fmaxf(fmaxf(S[4], S[5]), fmaxf(S[6], S[7]))); \
        mx = fmaxf(mx, fmaxf(fmaxf(fmaxf(S[8], S[9]), fmaxf(S[10], S[11])), fmaxf(fmaxf(S[12], S[13]), fmaxf(S[14], S[15])))); \
        mx = xhalf_max(mx); \
        if (__builtin_amdgcn_ballot_w64(mx > M) != 0) {     \
          const float mn_ = fmaxf(M, mx); const float al_ = __builtin_amdgcn_exp2f(M - mn_); M = mn_; L *= al_; \
          _Pragma("unroll") for (int i = 0; i < 16; i++) { O[0][i] *= al_; O[1][i] *= al_; } \
        } \
        float ls_ = 0.f; \
        _Pragma("unroll") for (int i = 0; i < 16; i++) { float pv_ = __builtin_amdgcn_exp2f(S[i] - M); S[i] = pv_; ls_ += pv_; } \
        L += ls_; \
        _Pragma("unroll") for (int sx = 0; sx < 2; sx++) { uint4 u_; u_.x = pack2(S[8 * sx], S[8 * sx + 1]); u_.y = pack2(S[8 * sx + 2], S[8 * sx + 3]); \
          u_.z = pack2(S[8 * sx + 4], S[8 * sx + 5]); u_.w = pack2(S[8 * sx + 6], S[8 * sx + 7]); PF[sx] = __builtin_bit_cast(bf16x8, u_); } }
      SOFTMAX_STEP(s0, m_run0, l_run0, o[0], pf0)
      SOFTMAX_STEP(s1, m_run1, l_run1, o[1], pf1)
#undef SOFTMAX_STEP
#pragma unroll
      for (int db = 0; db < 2; db++)
#pragma unroll
        for (int sx = 0; sx < 2; sx++) {
          const u16* vp = &Vs[buf][db * 32 + r][32 * kb + 16 * sx + 4 * h];
          uint2 lo = *(const uint2*)vp, hi = *(const uint2*)(vp + 8);
          uint4 u; u.x = lo.x; u.y = lo.y; u.z = hi.x; u.w = hi.y;
          const bf16x8 a = __builtin_bit_cast(bf16x8, u);
          __builtin_amdgcn_s_setprio(1);
          o[0][db] = MFMA(a, pf0[sx], o[0][db]);
          o[1][db] = MFMA(a, pf1[sx], o[1][db]);
          __builtin_amdgcn_s_setprio(0);
        }
    }
    if (t + 1 < nTiles) LSTORE(buf ^ 1);
    __syncthreads();
  }
#undef GLOAD
#undef LSTORE
#pragma unroll
  for (int qw = 0; qw < 2; qw++) {
    const float inv = __builtin_amdgcn_rcpf(xhalf_sum(qw ? l_run1 : l_run0));
    const int q = (w * 2 + qw) * 32 + r;
#pragma unroll
    for (int db = 0; db < 2; db++)
#pragma unroll
      for (int g = 0; g < 4; g++) {
        const int d0 = 32 * db + 8 * g + 4 * h;
        uint2 zz = *(const uint2*)(Zp + (size_t)q * PKW + d0);
        uint2 ov; ov.x = pack2(o[qw][db][4 * g] * inv * silu(bflo(zz.x)), o[qw][db][4 * g + 1] * inv * silu(bfhi(zz.x)));
        ov.y = pack2(o[qw][db][4 * g + 2] * inv * silu(bflo(zz.y)), o[qw][db][4 * g + 3] * inv * silu(bfhi(zz.y)));
        *(uint2*)(Gp + (size_t)q * 1024 + d0) = ov;
      }
  }
}

DI int fetch_item(unsigned* ctr, char* smem) {
  volatile int* slot = (volatile int*)(smem + SMEM_BYTES - 16);
  __syncthreads();
  if (threadIdx.x == 0) *slot = (int)__hip_atomic_fetch_add(ctr, 1u, __ATOMIC_RELAXED, __HIP_MEMORY_SCOPE_AGENT);
  __syncthreads();
  return *slot;
}

DI void phase_mix(const Params& p, int l, char* smem, int tid) {
  const bool need_ctx = (l == 0);
  const int NL = 1024, NC = need_ctx ? 64 : 0;
  const int NL2 = 512, NC2 = need_ctx ? 32 : 0, NT2 = NL2 + NC2;
  const int NLRU = need_ctx ? 8 * 68 * 4 : 8 * 64 * 4;
  const float scD = 0.125f * LOG2E;
  unsigned* q = p.bar + 4096 + l * 512;
#define DECODE2(it) int b, hd; size_t q0; int nT; \
    if ((it) < NL2) { b = (it) >> 6; hd = ((it) >> 4) & 3; q0 = (size_t)b * SEQA + CTXL + ((it) & 15) * 256; nT = 68; } \
    else { int j_ = (it) - NL2; b = j_ >> 2; hd = j_ & 3; q0 = (size_t)b * SEQA; nT = 4; }
#define DECODE_ITEM(it) int b, hd, qb; bool isctx; \
    if ((it) < NL) { b = (it) >> 7; hd = ((it) >> 5) & 3; qb = (it) & 31; isctx = false; } \
    else { int j_ = (it) - NL; b = j_ >> 3; hd = (j_ >> 1) & 3; qb = j_ & 1; isctx = true; } \
    const size_t q0 = (size_t)b * SEQA + (isctx ? 0 : CTXL) + qb * 128; const int nT = isctx ? 4 : 68;
  for (int it = fetch_item(q, smem); it < NT2; it = fetch_item(q, smem)) {
    DECODE2(it)
    const int hk = hd >> 1;
    attn_item2<64>(p.QD + q0 * 256 + hd * 64, 256, p.KD + ((size_t)b * 2 + hk) * SEQA * 64, 64, p.VtAD + ((size_t)b * 384 + 256 + hk * 64) * SEQA, nT,
                   p.G + q0 * 1024 + 768 + hd * 64, p.Pk + q0 * PKW + 768 + 768 + hd * 64, smem, tid);
  }
#undef DECODE2
  for (int it = fetch_item(q + 64, smem); it < NL + NC; it = fetch_item(q + 64, smem)) {
    DECODE_ITEM(it)
    attn_item<96, false>(p.QB + q0 * 384 + hd * 96, 384, p.KB + ((size_t)b * 4 + hd) * SEQA * 96, 96, p.VtB + ((size_t)b * 4 + hd) * 64 * SEQA, nT, 1.f,
                         0, 0, 0, nullptr, p.G + q0 * 1024 + 256 + hd * 64, p.Pk + q0 * PKW + 768 + 256 + hd * 64, smem, tid);
  }
  for (int it = fetch_item(q + 128, smem); it < NL; it = fetch_item(q + 128, smem)) {
    DECODE_ITEM(it)
    (void)isctx; (void)nT;
    const int rsA = clampi(2 * qb - 4, 0, 56), rsB = clampi(2 * qb + 1 - 4, 0, 56), nWin = rsB - rsA + 8;
    attn_item<64, true>(p.Pk + q0 * PKW + hd * 64, PKW, p.Pk + (size_t)b * SEQA * PKW + 256 + hd * 64, PKW, p.VtAD + ((size_t)b * 384 + hd * 64) * SEQA, nWin + 4, scD,
                        nWin, rsA, qb, p.relb + ((size_t)l * 4 + hd) * 465, p.G + q0 * 1024 + hd * 64, p.Pk + q0 * PKW + 768 + hd * 64, smem, tid);
  }
  for (int j = fetch_item(q + 192, smem); j < NC; j = fetch_item(q + 192, smem)) {
    const int it = NL + j;
    DECODE_ITEM(it)
    attn_item<64, false>(p.Pk + q0 * PKW + hd * 64, PKW, p.Pk + (size_t)b * SEQA * PKW + 256 + hd * 64, PKW, p.VtAD + ((size_t)b * 384 + hd * 64) * SEQA, nT, scD,
                         0, 0, 0, nullptr, p.G + q0 * 1024 + hd * 64, p.Pk + q0 * PKW + 768 + hd * 64, smem, tid);
  }
#undef DECODE_ITEM
  for (int j = fetch_item(q + 256, smem); j < NLRU; j = fetch_item(q + 256, smem)) {
    const int blk = j & 3;
    int chunk, b;
    if (need_ctx) { chunk = (j >> 2) % 68; b = (j >> 2) / 68; } else { chunk = 4 + ((j >> 2) & 63); b = (j >> 2) >> 6; }
    lru_item(p, l, b, chunk, blk, true, smem, tid);
  }
}

DI void phase_merge(const Params& p, int l, char* smem, int tid) {
  const int lane = tid & 63, w = tid >> 6, r = lane & 31, h = lane >> 5, wm = w >> 1, wn = w & 1;
  GemmLds* s = (GemmLds*)smem;
  u16* ACC = p.Pk;
  const bool dyn = (l == 0);
  unsigned* qc = p.bar + 4096 + 320;
  for (int it = (dyn ? fetch_item(qc, smem) : (int)blockIdx.x); it < 544 * 8; it = (dyn ? fetch_item(qc, smem) : it + (int)gridDim.x)) {
    const int mt = it >> 3, nt = it & 7, m0 = mt * 64, n0 = nt * 128;
    if (l == 1 && (mt % 68) < 4) continue;
    f32x16 accT[1][2]; zero_acc<1>(accT);
#pragma unroll 1
    for (int i = 0; i < 4; i++) {
      if ((ZERO_MASK >> i) & 1) continue;
      unsigned sg[2][8];
      {
        f32x16 m[1][2]; zero_acc<1>(m);
        gemm_main<1>(p.xn + (size_t)m0 * 1024, 1024, p.WtM + (size_t)l * 4096 * 1024 + ((size_t)i * 1024 + n0) * 1024, 1024, 1024, m, s, tid);
#pragma unroll
        for (int b2 = 0; b2 < 2; b2++)
#pragma unroll
          for (int e = 0; e < 8; e++) sg[b2][e] = pack2(sigm_fast(m[0][b2][2 * e]), sigm_fast(m[0][b2][2 * e + 1]));
      }
      f32x16 t[1][2]; zero_acc<1>(t);
      gemm_main<1>(p.G + (size_t)m0 * 1024 + i * 256, 1024, p.WtBr + ((size_t)l * 4 + i) * 1024 * 256 + (size_t)n0 * 256, 256, 256, t, s, tid);
#pragma unroll
      for (int b2 = 0; b2 < 2; b2++)
#pragma unroll
        for (int e = 0; e < 8; e++) { accT[0][b2][2 * e] += bflo(sg[b2][e]) * t[0][b2][2 * e]; accT[0][b2][2 * e + 1] += bfhi(sg[b2][e]) * t[0][b2][2 * e + 1]; }
    }
#pragma unroll
    for (int nb = 0; nb < 2; nb++) {
      const int rowb = m0 + wm * 32, col = n0 + wn * 64 + nb * 32 + r;
#pragma unroll
      for (int i = 0; i < 16; i++) ACC[(size_t)(rowb + crow(i, h)) * 1024 + col] = f2bf(accT[0][nb][i]);
    }
  }
}

DI void phase_outproj(const Params& p, int l, char* smem, int tid) {
  const int lane = tid & 63, w = tid >> 6, r = lane & 31, h = lane >> 5, wm = w >> 1, wn = w & 1;
  GemmLds* s = (GemmLds*)smem;
  const u16* ACC = p.Pk;
  const bool dyn = (l == 0);
  unsigned* qc = p.bar + 4096 + 384;
  for (int it = (dyn ? fetch_item(qc, smem) : (int)blockIdx.x); it < 272 * 8; it = (dyn ? fetch_item(qc, smem) : it + (int)gridDim.x)) {
    const int mt = it >> 3, nt = it & 7, m0 = mt * 128, n0 = nt * 128;
    if (l == 1 && (mt % 34) < 2) continue;
    f32x16 acc[2][2]; zero_acc<2>(acc);
    gemm_main<2>(ACC + (size_t)m0 * 1024, 1024, p.WtOut + (size_t)l * 1024 * 1024 + (size_t)n0 * 1024, 1024, 1024, acc, s, tid);
    u16* O = p.G;
#pragma unroll
    for (int mb = 0; mb < 2; mb++)
#pragma unroll
      for (int nb = 0; nb < 2; nb++) {
        const int rowb = m0 + wm * 64 + mb * 32, col = n0 + wn * 64 + nb * 32 + r;
        const int b = rowb / SEQA, pos0 = rowb % SEQA;
        const float gate = p.mod[((size_t)l * 9 + ((pos0 < CTXL) ? 8 : b)) * 3072 + 2048 + col];
#pragma unroll
        for (int i = 0; i < 16; i++) O[(size_t)(rowb + crow(i, h)) * 1024 + col] = f2bf(gate * acc[mb][nb][i]);
      }
  }
}

#if MULTI
DI void run_phase(const Params& p, int ph, char* smem, int tid) {
  if (ph == 0) { phase0(p, smem, tid); return; }
  if (ph == 1) { phase_ln0(p, tid); return; }
  const int l = (ph - 2) / 6, s = (ph - 2) % 6;
  switch (s) {
    case 0: phase_inproj(p, l, smem, tid); break;
    case 1: phase_prep(p, l, smem, tid); break;
    case 2: phase_mix(p, l, smem, tid); break;
    case 3: phase_merge(p, l, smem, tid); break;
    case 4: phase_outproj(p, l, smem, tid); break;
    default: phase_lnf(p, l, tid); break;
  }
}

#endif

struct KArgs { const float* in[25]; float* out; char* ws; };

constexpr size_t al256(size_t b) { return (b + 255) & ~(size_t)255; }
constexpr size_t OFF_XN = 0;
constexpr size_t OFF_PK = OFF_XN + al256((size_t)R * 1024 * 2);
constexpr size_t OFF_PT = OFF_PK + al256((size_t)R * PKW * 2);
constexpr size_t OFF_VTAD = OFF_PT + al256((size_t)R * PTW * 2);
constexpr size_t OFF_QB = OFF_VTAD + al256((size_t)NBATCH * 384 * SEQA * 2);
constexpr size_t OFF_KB = OFF_QB + al256((size_t)R * 384 * 2);
constexpr size_t OFF_VTB = OFF_KB + al256((size_t)NBATCH * 4 * SEQA * 96 * 2);
constexpr size_t OFF_QD = OFF_VTB + al256((size_t)NBATCH * 256 * SEQA * 2);
constexpr size_t OFF_KD = OFF_QD + al256((size_t)R * 256 * 2);
constexpr size_t OFF_G = OFF_KD + al256((size_t)NBATCH * 2 * SEQA * 64 * 2);
constexpr size_t OFF_WTIN = OFF_G + al256((size_t)R * 1024 * 2);
constexpr size_t OFF_WTM = OFF_WTIN + al256((size_t)2 * 3072 * 1024 * 2);
constexpr size_t OFF_WTUQ = OFF_WTM + al256((size_t)2 * 4096 * 1024 * 2);
constexpr size_t OFF_WTUKV = OFF_WTUQ + al256((size_t)2 * 384 * 256 * 2);
constexpr size_t OFF_WTA = OFF_WTUKV + al256((size_t)2 * 512 * 128 * 2);
constexpr size_t OFF_WTX = OFF_WTA + al256((size_t)2 * 8 * 4096 * 2);
constexpr size_t OFF_WTBR = OFF_WTX + al256((size_t)2 * 8 * 4096 * 2);
constexpr size_t OFF_WTOUT = OFF_WTBR + al256((size_t)2 * 4 * 1024 * 256 * 2);
constexpr size_t OFF_MOD = OFF_WTOUT + al256((size_t)2 * 1024 * 1024 * 2);
constexpr size_t OFF_AGG = OFF_MOD + al256((size_t)2 * 9 * 3072 * 4);
constexpr size_t OFF_CTXV = OFF_AGG + al256((size_t)NBATCH * 68 * 2 * 256 * 8);
constexpr size_t OFF_ROPEB = OFF_CTXV + al256((size_t)NBATCH * CTXL * 1024 * 4);
constexpr size_t OFF_ROPED = OFF_ROPEB + al256(64 * 8 * 2 * 4);
constexpr size_t OFF_SG = OFF_ROPED + al256(64 * 16 * 2 * 4);
constexpr size_t OFF_BAR = OFF_SG;
constexpr size_t WS_END = OFF_BAR + 32768;

DI int launder_i(int v) { asm volatile("" : "+v"(v)); return v; }
DI Params make_params(const KArgs& ka) {
  char* ws = ka.ws; float* out = ka.out;
  Params p;
  const float** pin = (const float**)&p;
#pragma unroll
  for (int i = 0; i < 25; i++) pin[i] = ka.in[i];
  p.out = out;
  p.xn = (u16*)(ws + OFF_XN); p.Pk = (u16*)(ws + OFF_PK); p.Pt = (u16*)(ws + OFF_PT); p.VtAD = (u16*)(ws + OFF_VTAD);
  p.QB = (u16*)(ws + OFF_QB); p.KB = (u16*)(ws + OFF_KB); p.VtB = (u16*)(ws + OFF_VTB); p.QD = (u16*)(ws + OFF_QD); p.KD = (u16*)(ws + OFF_KD); p.G = (u16*)(ws + OFF_G);
  p.WtIn = (u16*)(ws + OFF_WTIN); p.WtM = (u16*)(ws + OFF_WTM); p.WtUq = (u16*)(ws + OFF_WTUQ); p.WtUkv = (u16*)(ws + OFF_WTUKV);
  p.WtA = (u16*)(ws + OFF_WTA); p.WtX = (u16*)(ws + OFF_WTX); p.WtBr = (u16*)(ws + OFF_WTBR); p.WtOut = (u16*)(ws + OFF_WTOUT);
  p.mod = (float*)(ws + OFF_MOD); p.agg = (float*)(ws + OFF_AGG); p.ctxV = (float*)(ws + OFF_CTXV); p.ropeB = (float*)(ws + OFF_ROPEB); p.ropeD = (float*)(ws + OFF_ROPED); p.sgbuf = ws + OFF_SG; p.bar = (unsigned*)(ws + OFF_BAR);
  return p;
}

#define XB_TMO      128
#define XB_XCNT(j)  (256  + 64 * (j))
#define XB_XSUB(j)  (1280 + 64 * (j))
#define XB_XGEN(j)  (2304 + 64 * (j))
#define XB_TOP      3328
#define XB_TOPGEN   3392
#define XCD_BAR_WORDS 3456
#define XB_SPIN_CAP (1u << 24)
DI unsigned xb_ld(unsigned* p) { return __hip_atomic_load(p, __ATOMIC_RELAXED, __HIP_MEMORY_SCOPE_AGENT); }
DI unsigned xb_add(unsigned* p, unsigned v) { return __hip_atomic_fetch_add(p, v, __ATOMIC_RELAXED, __HIP_MEMORY_SCOPE_AGENT); }
DI unsigned xb_xcc_id() { return (unsigned)__builtin_amdgcn_s_getreg((3 << 11) | 20) & 0xFu; }
#define XB_SPIN(cond, bar) do { unsigned _sp = 0; while (cond) { __builtin_amdgcn_s_sleep(1); \
    if ((++_sp & 255u) == 0u) { if (xb_ld(&(bar)[XB_TMO])) break; if (_sp > XB_SPIN_CAP) { atomicAdd(&(bar)[XB_TMO], 1u); break; } } } } while (0)

DI void xcd_census(unsigned* bar, unsigned x, unsigned& nloc, unsigned& nx) {
  const unsigned G = gridDim.x;
  unsigned sum, cnt, mine, sp = 0u;
  for (;;) {
    sum = 0u; cnt = 0u; mine = 0u;
#pragma unroll
    for (unsigned j = 0; j < 16; ++j) { const unsigned c = xb_ld(&bar[XB_XCNT(j)]); sum += c; cnt += (c > 0u) ? 1u : 0u; mine = (j == x) ? c : mine; }
    if (sum == G) break;
    __builtin_amdgcn_s_sleep(1);
    if ((++sp & 255u) == 0u) { if (xb_ld(&bar[XB_TMO])) break; if (sp > XB_SPIN_CAP) { atomicAdd(&bar[XB_TMO], 1u); break; } }
  }
  nloc = mine > 0u ? mine : 1u; nx = cnt > 0u ? cnt : 1u;
}

DI void xcd_barrier(unsigned* bar, unsigned x, volatile unsigned* st) {
  asm volatile("s_waitcnt vmcnt(0)" ::: "memory");
  __syncthreads();
  if (threadIdx.x == 0) {
    __builtin_amdgcn_s_waitcnt(0);
    unsigned nloc = st[0], nx = st[1];
    if (nloc == 0u) { xcd_census(bar, x, nloc, nx); st[0] = nloc; st[1] = nx; }
    const unsigned old = xb_add(&bar[XB_XSUB(x)], 1u);
    const unsigned gen = old / nloc;
    if (old + 1u == (gen + 1u) * nloc) {
      __builtin_amdgcn_fence(__ATOMIC_RELEASE, "agent");
      asm volatile("s_waitcnt vmcnt(0)" ::: "memory");
      const unsigned og = xb_add(&bar[XB_TOP], 1u);
      const unsigned tg = og / nx;
      if (og + 1u == (tg + 1u) * nx) xb_add(&bar[XB_TOPGEN], 1u);
      else XB_SPIN(xb_ld(&bar[XB_TOPGEN]) == tg, bar);
      __builtin_amdgcn_fence(__ATOMIC_ACQUIRE, "agent");
      xb_add(&bar[XB_XGEN(x)], 1u);
      asm volatile("s_waitcnt vmcnt(0)" ::: "memory");
    } else {
      XB_SPIN(xb_ld(&bar[XB_XGEN(x)]) == gen, bar);
      __builtin_amdgcn_fence(__ATOMIC_ACQUIRE, "agent");
      asm volatile("s_waitcnt vmcnt(0)" ::: "memory");
    }
  }
  __syncthreads();
}

__global__ void __launch_bounds__(256, 2) mega_kernel(KArgs ka) {
  __shared__ __attribute__((aligned(16))) char smem[SMEM_BYTES];
  __shared__ uint4 xb_words;
  cg::grid_group grid = cg::this_grid();
  const int tid = threadIdx.x;
  unsigned* const bar = (unsigned*)(ka.ws + OFF_BAR);
  if (tid == 0) xb_words = make_uint4(0u, 0u, 0u, 0u);
  if (ka.ws == nullptr) grid.sync();
  if (tid == 0) (void)xb_add(&((unsigned*)(ka.ws + OFF_BAR))[XB_XCNT(xb_xcc_id())], 1u);
#define GRID_BAR() xcd_barrier((unsigned*)(ka.ws + OFF_BAR), xb_xcc_id(), (volatile unsigned*)&xb_words)
  { Params p = make_params(ka); phase0(p, smem, launder_i(tid)); } GRID_BAR();
  { Params p = make_params(ka); phase_ln0(p, launder_i(tid)); } GRID_BAR();
#pragma unroll 1
  for (int l = 0; l < 2; l++) {
    { Params p = make_params(ka); phase_inproj(p, l, smem, launder_i(tid)); } GRID_BAR();
    { Params p = make_params(ka); phase_prep(p, l, smem, launder_i(tid)); } GRID_BAR();
    { Params p = make_params(ka); phase_mix(p, l, smem, launder_i(tid)); } GRID_BAR();
    { Params p = make_params(ka); phase_merge(p, l, smem, launder_i(tid)); } GRID_BAR();
    { Params p = make_params(ka); phase_outproj(p, l, smem, launder_i(tid)); } GRID_BAR();
    { Params p = make_params(ka); phase_lnf(p, l, launder_i(tid)); }
    if (l == 0) GRID_BAR();
  }
#undef GRID_BAR
}

#if MULTI
__global__ void __launch_bounds__(256, 2) phase_kernel(KArgs ka, int ph) {
  __shared__ __attribute__((aligned(16))) char smem[SMEM_BYTES];
  Params p = make_params(ka);
  run_phase(p, ph, smem, threadIdx.x);
}

#endif

extern "C" void kernel_launch(void* const* d_in, const int* in_sizes, int n_in, void* d_out, int out_size, void* d_ws, size_t ws_size, hipStream_t stream) {
  static int grid_blocks = 0;
  if (!grid_blocks) {
    int dev = 0, cus = 0, per_cu = 0;
    hipGetDevice(&dev);
    hipDeviceGetAttribute(&cus, hipDeviceAttributeMultiprocessorCount, dev);
    hipOccupancyMaxActiveBlocksPerMultiprocessor(&per_cu, mega_kernel, 256, 0);
    if (per_cu < 1) per_cu = 1;
    if (per_cu > 2) per_cu = 2;
    grid_blocks = cus * per_cu;
  }
  if (WS_END > ws_size) { fprintf(stderr, "kernel_launch: workspace too small: need %zu, have %zu\n", (size_t)WS_END, ws_size); return; }
  KArgs ka{};
  for (int i = 0; i < 25; i++) ka.in[i] = (const float*)d_in[i];
  ka.out = (float*)d_out; ka.ws = (char*)d_ws;
#if MULTI
  for (int ph = 0; ph < NPHASE; ph++) hipLaunchKernelGGL(phase_kernel, dim3(grid_blocks), dim3(256), 0, stream, ka, ph);
#else
  (void)hipMemsetAsync((char*)d_ws + OFF_BAR, 0, 32768, stream);
  void* args[] = {&ka};
  hipError_t e = hipLaunchCooperativeKernel((void*)mega_kernel, dim3(grid_blocks), dim3(256), args, 0, stream);
  if (e != hipSuccess) fprintf(stderr, "cooperative launch failed: %s (grid %d)\n", hipGetErrorString(e), grid_blocks);
#endif
}
```

```cpp
#include <hip/hip_runtime.h>
#include <hip/hip_cooperative_groups.h>
#include <cstdio>
namespace cg = cooperative_groups;

#ifndef MULTI
#define MULTI 0
#endif
#ifndef ZERO_MASK
#define ZERO_MASK 0
#endif
#ifndef DUP_PHASE
#define DUP_PHASE 0
#endif
#ifndef DUP_MIX
#define DUP_MIX 0
#endif

typedef unsigned short u16;
using bf16x8 = __attribute__((ext_vector_type(8))) short;
using f32x16 = __attribute__((ext_vector_type(16))) float;
#define DI __device__ __forceinline__
#define MFMA(a, b, c) __builtin_amdgcn_mfma_f32_32x32x16_bf16((a), (b), (c), 0, 0, 0)

constexpr int DM = 1024, NBATCH = 8, SEQ = 4096, CTXL = 256, SEQA = 4352, R = NBATCH * SEQA;
constexpr int NIN = 7072, PKW = 1792, PTW = 800;
constexpr float EPS = 1e-6f, LOG2E = 1.4426950408889634f;
constexpr float ALPHA = 1.4142135623730951f;
constexpr int SMEM_BYTES = 75264;
constexpr int NPHASE = 14;

struct Params {
  const float *x, *c, *ctx, *c_ctx, *w_mod, *b_mod, *w_in, *relb, *qn, *wuq, *kvn, *wukv, *cw, *cb, *wa, *ba, *wx, *bx, *lam, *gqn, *gkn, *wbr, *wout, *lng, *lnb;
  float* out;
  u16 *xn, *Pk, *Pt, *VtAD, *QB, *KB, *VtB, *QD, *KD, *G;
  u16 *WtIn, *WtM, *WtUq, *WtUkv, *WtA, *WtX, *WtBr, *WtOut;
  float *mod, *agg, *ctxV, *ropeB, *ropeD;
  char* sgbuf;
  unsigned* bar;
};

typedef __bf16 bf16v2 __attribute__((ext_vector_type(2)));
typedef float f32v2 __attribute__((ext_vector_type(2)));
DI unsigned pack2(float a, float b) { f32v2 v = {a, b}; return __builtin_bit_cast(unsigned, __builtin_convertvector(v, bf16v2)); }
DI u16 f2bf(float x) { return (u16)(pack2(x, 0.f) & 0xffffu); }
DI float bf2f(u16 v) { return __uint_as_float(((unsigned)v) << 16); }
DI float bflo(unsigned v) { return __uint_as_float(v << 16); }
DI float bfhi(unsigned v) { return __uint_as_float(v & 0xffff0000u); }
DI float sigm(float x) { return __builtin_amdgcn_rcpf(1.f + __expf(-x)); }
DI float silu(float x) { return x * sigm(x); }
DI float sigm_fast(float x) { return __builtin_amdgcn_rcpf(1.f + __expf(-x)); }
template <int CTRL> DI float dpp_mov(float v) { return __int_as_float(__builtin_amdgcn_update_dpp(0, __float_as_int(v), CTRL, 0xf, 0xf, false)); }
DI float wave_sum(float v) {
  v += dpp_mov<0xB1>(v);
  v += dpp_mov<0x4E>(v);
  v += dpp_mov<0x141>(v);
  v += dpp_mov<0x140>(v);
  { auto r = __builtin_amdgcn_permlane16_swap(__float_as_uint(v), __float_as_uint(v), false, false); v = __uint_as_float(r[0]) + __uint_as_float(r[1]); }
  { auto r = __builtin_amdgcn_permlane32_swap(__float_as_uint(v), __float_as_uint(v), false, false); v = __uint_as_float(r[0]) + __uint_as_float(r[1]); }
  return v;
}
DI float xhalf_max(float v) { auto r = __builtin_amdgcn_permlane32_swap(__float_as_uint(v), __float_as_uint(v), false, false); return fmaxf(__uint_as_float(r[0]), __uint_as_float(r[1])); }
DI float xhalf_sum(float v) { auto r = __builtin_amdgcn_permlane32_swap(__float_as_uint(v), __float_as_uint(v), false, false); return __uint_as_float(r[0]) + __uint_as_float(r[1]); }
DI int crow(int i, int h) { return (i & 3) + 8 * (i >> 2) + 4 * h; }
DI int clampi(int v, int lo, int hi) { return v < lo ? lo : (v > hi ? hi : v); }

struct GemmLds { u16 a[2][128][72]; u16 b[2][128][72]; };

template <int MB, bool PF2 = true>
DI void gemm_main(const u16* __restrict__ A, int lda, const u16* __restrict__ B, int ldb, int K, f32x16 (&acc)[MB][2], GemmLds* s, int tid) {
  const int lane = tid & 63, w = tid >> 6, r = lane & 31, h = lane >> 5, wm = w >> 1, wn = w & 1;
  const int srow = tid >> 3, skc = (tid & 7) * 8;
  const unsigned oa0 = (unsigned)(srow * lda + skc) * 2u, oa1 = oa0 + 64u * lda, oa2 = oa0 + 128u * lda, oa3 = oa0 + 192u * lda;
  const unsigned ob0 = (unsigned)(srow * ldb + skc) * 2u, ob1 = ob0 + 64u * ldb, ob2 = ob0 + 128u * ldb, ob3 = ob0 + 192u * ldb;
  uint4 pa0, pa1, pa2, pa3, pb0, pb1, pb2, pb3, qa0, qa1, qa2, qa3, qb0, qb1, qb2, qb3;
  pa2 = pa3 = qa2 = qa3 = make_uint4(0, 0, 0, 0);
#define G_LOAD(S, k0) { const char* ua_ = (const char*)(A + (k0)); const char* ub_ = (const char*)(B + (k0)); \
    S##a0 = *(const uint4*)(ua_ + oa0); S##a1 = *(const uint4*)(ua_ + oa1); \
    if (MB == 2) { S##a2 = *(const uint4*)(ua_ + oa2); S##a3 = *(const uint4*)(ua_ + oa3); } \
    S##b0 = *(const uint4*)(ub_ + ob0); S##b1 = *(const uint4*)(ub_ + ob1); S##b2 = *(const uint4*)(ub_ + ob2); S##b3 = *(const uint4*)(ub_ + ob3); }
#define G_STORE(S, bf) { *(uint4*)&s->a[bf][srow][skc] = S##a0; *(uint4*)&s->a[bf][srow + 32][skc] = S##a1; \
    if (MB == 2) { *(uint4*)&s->a[bf][srow + 64][skc] = S##a2; *(uint4*)&s->a[bf][srow + 96][skc] = S##a3; } \
    *(uint4*)&s->b[bf][srow][skc] = S##b0; *(uint4*)&s->b[bf][srow + 32][skc] = S##b1; *(uint4*)&s->b[bf][srow + 64][skc] = S##b2; *(uint4*)&s->b[bf][srow + 96][skc] = S##b3; }
#define G_COMPUTE(bf) { _Pragma("unroll") for (int ks = 0; ks < 4; ks++) { \
      bf16x8 af[MB], bfr[2]; \
      _Pragma("unroll") for (int mb = 0; mb < MB; mb++) af[mb] = *(const bf16x8*)&s->a[bf][wm * (32 * MB) + mb * 32 + r][ks * 16 + h * 8]; \
      _Pragma("unroll") for (int nb = 0; nb < 2; nb++) bfr[nb] = *(const bf16x8*)&s->b[bf][wn * 64 + nb * 32 + r][ks * 16 + h * 8]; \
      _Pragma("unroll") for (int mb = 0; mb < MB; mb++) _Pragma("unroll") for (int nb = 0; nb < 2; nb++) acc[mb][nb] = MFMA(af[mb], bfr[nb], acc[mb][nb]); } }
  int KT = K >> 6;
  asm volatile("" : "+s"(KT));
  __syncthreads();
  G_LOAD(p, 0); G_STORE(p, 0);
  if (!PF2) {
    __syncthreads();
    for (int kt = 0; kt < KT; kt++) {
      const int buf = kt & 1;
      if (kt + 1 < KT) G_LOAD(p, (kt + 1) * 64);
      if (buf) { G_COMPUTE(1); } else { G_COMPUTE(0); }
      if (kt + 1 < KT) { if (buf) { G_STORE(p, 0); } else { G_STORE(p, 1); } }
      __syncthreads();
    }
    return;
  }
  const int klast = K - 64;
  G_LOAD(p, 64);
  __syncthreads();
  for (int kt = 0; kt < KT; kt += 2) {
    { const int k2 = min((kt + 2) * 64, klast); G_LOAD(q, k2); }
    __builtin_amdgcn_sched_barrier(0);
    G_COMPUTE(0);
    G_STORE(p, 1);
    __syncthreads();
    { const int k3 = min((kt + 3) * 64, klast); G_LOAD(p, k3); }
    __builtin_amdgcn_sched_barrier(0);
    G_COMPUTE(1);
    G_STORE(q, 0);
    __syncthreads();
  }
#undef G_LOAD
#undef G_STORE
#undef G_COMPUTE
}

template <int MB>
DI void zero_acc(f32x16 (&acc)[MB][2]) {
#pragma unroll
  for (int a = 0; a < MB; a++)
#pragma unroll
    for (int b = 0; b < 2; b++)
#pragma unroll
      for (int i = 0; i < 16; i++) acc[a][b][i] = 0.f;
}

DI void row_rs(const u16* A, int lda, int K, float* rs, int tid) {
  const int row = tid >> 1, half = tid & 1, len = K >> 1;
  const u16* p = A + (size_t)row * lda + half * len;
  float ss = 0.f;
  for (int j = 0; j < len; j += 8) {
    uint4 v = *(const uint4*)(p + j);
    float a0 = bflo(v.x), a1 = bfhi(v.x), a2 = bflo(v.y), a3 = bfhi(v.y), a4 = bflo(v.z), a5 = bfhi(v.z), a6 = bflo(v.w), a7 = bfhi(v.w);
    ss += a0 * a0 + a1 * a1 + a2 * a2 + a3 * a3 + a4 * a4 + a5 * a5 + a6 * a6 + a7 * a7;
  }
  ss += dpp_mov<0xB1>(ss);
  if (half == 0) rs[row] = rsqrtf(ss / (float)K + EPS);
}

DI void sincos_red(float x, float& sn, float& cs) {
  const float k = rintf(x * 0.15915494309189535f);
  float y = fmaf(-k, 6.2831854820251465f, x);
  y = fmaf(-k, -1.7484555e-7f, y);
  sn = __sinf(y); cs = __cosf(y);
}

DI int win_srccol(int n) {
  if (n < 512) return n;
  if (n < 768) return 1184 + (n - 512);
  if (n < 1792) return 1952 + (n - 768);
  if (n < 2048) return 768 + (n - 1792);
  if (n < 2176) return 1024 + (n - 2048);
  if (n < 2208) return 1152 + (n - 2176);
  if (n < 2464) return 1440 + (n - 2208);
  if (n < 2592) return 1696 + (n - 2464);
  if (n < 2848) return 512 + (n - 2592);
  if (n < 2976) return 1824 + (n - 2848);
  return -1;
}

DI void convT_item(const float* __restrict__ src, int ld, int K, int kq, int n0, int mode, int coloff, const float* __restrict__ scale, u16* __restrict__ dst, int tid) {
  const int lane = tid & 63, wv = tid >> 6;
  const int n = n0 + lane;
  const int sc = (mode == 1) ? win_srccol(n) : (coloff + n);
#pragma unroll 4
  for (int j = 0; j < 8; j++) {
    const int k0 = kq * 256 + (wv + 4 * j) * 8;
    if (k0 >= K) break;
    float v[8];
#pragma unroll
    for (int e = 0; e < 8; e++) {
      float t = (sc >= 0) ? src[(size_t)(k0 + e) * ld + sc] : 0.f;
      if (scale) t *= scale[k0 + e];
      v[e] = t;
    }
    uint4 o; o.x = pack2(v[0], v[1]); o.y = pack2(v[2], v[3]); o.z = pack2(v[4], v[5]); o.w = pack2(v[6], v[7]);
    *(uint4*)(dst + (size_t)n * K + k0) = o;
  }
}

DI void mod_item(const Params& p, int it, char* smem, int tid) {
  const int l = it / 96, cg0 = (it % 96) * 32;
  float* s = (float*)smem;
  float* red = s + 9 * 1024;
  __syncthreads();
  for (int i = tid; i < 9 * 1024; i += 256) { int j = i >> 10, k = i & 1023; float v = (j < 8) ? p.c[j * 1024 + k] : p.c_ctx[k]; s[i] = silu(v); }
  __syncthreads();
  const int kg = tid >> 5, cl = tid & 31;
  float acc[9];
#pragma unroll
  for (int j = 0; j < 9; j++) acc[j] = 0.f;
  const float* wp = p.w_mod + (size_t)l * 1024 * 3072 + cg0 + cl;
#pragma unroll 16
  for (int k = kg * 128; k < kg * 128 + 128; k++) {
    float wv = wp[(size_t)k * 3072];
#pragma unroll
    for (int j = 0; j < 9; j++) acc[j] += s[j * 1024 + k] * wv;
  }
#pragma unroll
  for (int j = 0; j < 9; j++) red[(kg * 9 + j) * 32 + cl] = acc[j];
  __syncthreads();
  for (int i = tid; i < 288; i += 256) {
    int j = i >> 5, c2 = i & 31; float t = 0.f;
    for (int g = 0; g < 8; g++) t += red[(g * 9 + j) * 32 + c2];
    p.mod[((size_t)l * 9 + j) * 3072 + cg0 + c2] = t + p.b_mod[l * 3072 + cg0 + c2];
  }
}

DI void phase0(const Params& p, char* smem, int tid) {
  const int NCONV = 606;
  const int total = 193 + 2 * NCONV;
  for (int it = blockIdx.x; it < total; it += gridDim.x) {
    if (it < 192) { mod_item(p, it, smem, tid); continue; }
    if (it == 192) {
      for (int i = tid; i < 64 * 16; i += 256) { int pos = i >> 4, f = i & 15; float inv = exp2f(-(float)f * (13.287712379549449f / 16.f)); float sn, cs; sincos_red((float)pos * inv, sn, cs); p.ropeD[2 * i] = cs; p.ropeD[2 * i + 1] = sn; }
      for (int i = tid; i < 64 * 8; i += 256) { int pos = i >> 3, f = i & 7; float inv = exp2f(-(float)f * (13.287712379549449f / 8.f)); float sn, cs; sincos_red((float)pos * inv, sn, cs); p.ropeB[2 * i] = cs; p.ropeB[2 * i + 1] = sn; }
      continue;
    }
    int j = it - 193; const int l = j / NCONV; j -= l * NCONV;
    if (j < 192) { convT_item(p.w_in + (size_t)l * 1024 * NIN, NIN, 1024, j & 3, (j >> 2) * 64, 1, 0, nullptr, p.WtIn + (size_t)l * 3072 * 1024, tid); }
    else if (j < 448) { int jj = j - 192; convT_item(p.w_in + (size_t)l * 1024 * NIN, NIN, 1024, jj & 3, (jj >> 2) * 64, 0, 2976, nullptr, p.WtM + (size_t)l * 4096 * 1024, tid); }
    else if (j < 454) { int nt = j - 448; convT_item(p.wuq + (size_t)l * 256 * 384, 384, 256, 0, nt * 64, 0, 0, p.qn + l * 256, p.WtUq + (size_t)l * 384 * 256, tid); }
    else if (j < 462) { int nt = j - 454; convT_item(p.wukv + (size_t)l * 128 * 512, 512, 128, 0, nt * 64, 0, 0, p.kvn + l * 128, p.WtUkv + (size_t)l * 512 * 128, tid); }
    else if (j < 470) { int m = j - 462; convT_item(p.wa + ((size_t)l * 8 + m) * 4096, 64, 64, 0, 0, 0, 0, nullptr, p.WtA + ((size_t)l * 8 + m) * 4096, tid); }
    else if (j < 478) { int m = j - 470; convT_item(p.wx + ((size_t)l * 8 + m) * 4096, 64, 64, 0, 0, 0, 0, nullptr, p.WtX + ((size_t)l * 8 + m) * 4096, tid); }
    else if (j < 542) { int jj = j - 478; int i = jj >> 4, nt = jj & 15; convT_item(p.wbr + ((size_t)l * 4 + i) * 256 * 1024, 1024, 256, 0, nt * 64, 0, 0, nullptr, p.WtBr + ((size_t)l * 4 + i) * 1024 * 256, tid); }
    else { int jj = j - 542; convT_item(p.wout + (size_t)l * 1024 * 1024, 1024, 1024, jj & 3, (jj >> 2) * 64, 0, 0, nullptr, p.WtOut + (size_t)l * 1024 * 1024, tid); }
  }
}

DI void ln_stats(const float4 (&v)[4], float& mean, float& rstd) {
  float s = 0.f;
#pragma unroll
  for (int j = 0; j < 4; j++) s += v[j].x + v[j].y + v[j].z + v[j].w;
  mean = wave_sum(s) * (1.f / 1024.f);
  float q = 0.f;
#pragma unroll
  for (int j = 0; j < 4; j++) { float a = v[j].x - mean, b = v[j].y - mean, c2 = v[j].z - mean, d = v[j].w - mean; q += a * a + b * b + c2 * c2 + d * d; }
  rstd = rsqrtf(wave_sum(q) * (1.f / 1024.f) + EPS);
}

DI void write_xn(const Params& p, int l, int row, int jm, const float4 (&v)[4], float mean, float rstd, int lane) {
  const float* md = p.mod + ((size_t)l * 9 + jm) * 3072;
#pragma unroll
  for (int j = 0; j < 4; j++) {
    const int col = 4 * (lane + 64 * j);
    float4 sh = *(const float4*)(md + col), scl = *(const float4*)(md + 1024 + col);
    float a = (v[j].x - mean) * rstd * (1.f + scl.x) + sh.x, b = (v[j].y - mean) * rstd * (1.f + scl.y) + sh.y;
    float c2 = (v[j].z - mean) * rstd * (1.f + scl.z) + sh.z, d = (v[j].w - mean) * rstd * (1.f + scl.w) + sh.w;
    uint2 o; o.x = pack2(a, b); o.y = pack2(c2, d);
    *(uint2*)(p.xn + (size_t)row * 1024 + col) = o;
  }
}

DI const float* ln0_src(const Params& p, int row) {
  const int b = row / SEQA, pos = row % SEQA;
  return (pos < CTXL) ? p.ctx + ((size_t)b * CTXL + pos) * 1024 : p.x + ((size_t)b * SEQ + pos - CTXL) * 1024;
}
DI void phase_ln0(const Params& p, int tid) {
  const int lane = tid & 63, w = tid >> 6;
  const int stride = gridDim.x * 4;
  int row = blockIdx.x * 4 + w;
  float4 v[4], nv[4];
  if (row < R) { const float* src = ln0_src(p, row);
#pragma unroll
    for (int j = 0; j < 4; j++) v[j] = *(const float4*)(src + 4 * (lane + 64 * j)); }
  while (row < R) {
    const int nrow = row + stride;
    if (nrow < R) { const float* nsrc = ln0_src(p, nrow);
#pragma unroll
      for (int j = 0; j < 4; j++) nv[j] = *(const float4*)(nsrc + 4 * (lane + 64 * j)); }
    __builtin_amdgcn_sched_barrier(0);
    const int b = row / SEQA, pos = row % SEQA;
    float mean, rstd; ln_stats(v, mean, rstd);
    write_xn(p, 0, row, pos < CTXL ? 8 : b, v, mean, rstd, lane);
#pragma unroll
    for (int j = 0; j < 4; j++) v[j] = nv[j];
    row = nrow;
  }
}

DI const float* lnf_res(const Params& p, int l, int row) {
  const int b = row / SEQA, pos = row % SEQA;
  if (pos < CTXL) return p.ctx + ((size_t)b * CTXL + pos) * 1024;
  return (l == 0 ? p.x : (const float*)p.out) + ((size_t)b * SEQ + pos - CTXL) * 1024;
}
DI void phase_lnf(const Params& p, int l, int tid) {
  const int lane = tid & 63, w = tid >> 6;
  const int stride = gridDim.x * 4;
  int row = blockIdx.x * 4 + w;
  float4 v[4], nv[4]; uint2 ov[4], nov[4];
  if (row < R) { const float* src = lnf_res(p, l, row); const u16* os = p.G + (size_t)row * 1024;
#pragma unroll
    for (int j = 0; j < 4; j++) { v[j] = *(const float4*)(src + 4 * (lane + 64 * j)); ov[j] = *(const uint2*)(os + 4 * (lane + 64 * j)); } }
  while (row < R) {
    const int nrow = row + stride;
    if (nrow < R) { const float* nsrc = lnf_res(p, l, nrow); const u16* nos = p.G + (size_t)nrow * 1024;
#pragma unroll
      for (int j = 0; j < 4; j++) { nv[j] = *(const float4*)(nsrc + 4 * (lane + 64 * j)); nov[j] = *(const uint2*)(nos + 4 * (lane + 64 * j)); } }
    __builtin_amdgcn_sched_barrier(0);
    const int b = row / SEQA, pos = row % SEQA;
    if (!(l == 1 && pos < CTXL)) {
      float* dst = (pos < CTXL) ? p.ctxV + ((size_t)b * CTXL + pos) * 1024 : p.out + ((size_t)b * SEQ + pos - CTXL) * 1024;
#pragma unroll
      for (int j = 0; j < 4; j++) {
        v[j].x = ALPHA * v[j].x + bflo(ov[j].x); v[j].y = ALPHA * v[j].y + bfhi(ov[j].x);
        v[j].z = ALPHA * v[j].z + bflo(ov[j].y); v[j].w = ALPHA * v[j].w + bfhi(ov[j].y);
      }
      float mean, rstd; ln_stats(v, mean, rstd);
#pragma unroll
      for (int j = 0; j < 4; j++) {
        const int col = 4 * (lane + 64 * j);
        float4 g = *(const float4*)(p.lng + l * 1024 + col), bb = *(const float4*)(p.lnb + l * 1024 + col);
        v[j].x = (v[j].x - mean) * rstd * g.x + bb.x; v[j].y = (v[j].y - mean) * rstd * g.y + bb.y;
        v[j].z = (v[j].z - mean) * rstd * g.z + bb.z; v[j].w = (v[j].w - mean) * rstd * g.w + bb.w;
        if (pos >= CTXL) *(float4*)(dst + col) = v[j];
      }
      if (l == 0) { ln_stats(v, mean, rstd); write_xn(p, 1, row, pos < CTXL ? 8 : b, v, mean, rstd, lane); }
    }
#pragma unroll
    for (int j = 0; j < 4; j++) { v[j] = nv[j]; ov[j] = nov[j]; }
    row = nrow;
  }
}

DI void vt_store32(const float (&v)[2][16], u16* T, u16* g, int lane) {
  const int r = lane & 31, h = lane >> 5;
#pragma unroll
  for (int mb = 0; mb < 2; mb++)
#pragma unroll
    for (int g4 = 0; g4 < 4; g4++) {
      uint2 o; o.x = pack2(v[mb][4 * g4], v[mb][4 * g4 + 1]); o.y = pack2(v[mb][4 * g4 + 2], v[mb][4 * g4 + 3]);
      *(uint2*)(T + r * 72 + mb * 32 + 8 * g4 + 4 * h) = o;
    }
  asm volatile("" ::: "memory");
#pragma unroll
  for (int j = 0; j < 4; j++) {
    const int cc = (lane >> 3) + 8 * j, tc = lane & 7;
    const uint4 x = *(const uint4*)(T + cc * 72 + tc * 8);
    *(uint4*)(g + (size_t)cc * SEQA + tc * 8) = x;
  }
  asm volatile("" ::: "memory");
}

DI void phase_inproj(const Params& p, int l, char* smem, int tid) {
  const int lane = tid & 63, w = tid >> 6, r = lane & 31, h = lane >> 5, wm = w >> 1, wn = w & 1;
  GemmLds* s = (GemmLds*)smem;
  const u16* Wt = p.WtIn + (size_t)l * 3072 * 1024;
  for (int it = blockIdx.x; it < 272 * 24; it += gridDim.x) {
    const int mt = it / 24, nt = it % 24, m0 = mt * 128, n0 = nt * 128;
    f32x16 acc[2][2]; zero_acc<2>(acc);
    gemm_main<2>(p.xn + (size_t)m0 * 1024, 1024, Wt + (size_t)n0 * 1024, 1024, 1024, acc, s, tid);
#pragma unroll
    for (int mb = 0; mb < 2; mb++)
#pragma unroll
      for (int nb = 0; nb < 2; nb++) {
        const int rowb = m0 + wm * 64 + mb * 32, colb = n0 + wn * 64 + nb * 32, col = colb + r;
        if (colb < 1792) {
          const float qs = (colb < 256) ? 0.125f * LOG2E : 1.f;
#pragma unroll
          for (int i = 0; i < 16; i++) p.Pk[(size_t)(rowb + crow(i, h)) * PKW + col] = f2bf(acc[mb][nb][i] * qs);
        } else if (colb < 2592) {
#pragma unroll
          for (int i = 0; i < 16; i++) p.Pt[(size_t)(rowb + crow(i, h)) * PTW + col - 1792] = f2bf(acc[mb][nb][i]);
        }
      }
#pragma unroll
    for (int nb = 0; nb < 2; nb++) {
      const int colb = n0 + wn * 64 + nb * 32;
      if (colb >= 2592 && colb < 2976) {
        const int rw = m0 + wm * 64;
        float v[2][16];
#pragma unroll
        for (int mb = 0; mb < 2; mb++)
#pragma unroll
          for (int i = 0; i < 16; i++) v[mb][i] = acc[mb][nb][i];
        vt_store32(v, (u16*)smem + w * (32 * 72), p.VtAD + ((size_t)(rw / SEQA) * 384 + colb - 2592) * SEQA + rw % SEQA, lane);
      }
    }
  }
}

DI void lru_item(const Params& p, int l, int b, int chunk, int blk, bool fin, char* smem, int tid) {
  const int lane = tid & 63, w = tid >> 6, r = lane & 31, h = lane >> 5;
  u16 (*xcb)[72] = (u16(*)[72])smem;
  float2* au = (float2*)(smem + 9216);
  u16* xr = (u16*)(smem + 9216);
  const int pos0 = chunk * 64, c0 = blk * 64;
  const int segLo = (chunk < 4) ? 0 : CTXL, segHi = (chunk < 4) ? CTXL : SEQA;
  __syncthreads();
  for (int cidx = tid; cidx < 68 * 8; cidx += 256) {
    const int t = cidx >> 3, kc = cidx & 7, pos = pos0 + t - 2;
    uint4 v = make_uint4(0, 0, 0, 0);
    if (pos >= segLo && pos < segHi) v = *(const uint4*)(p.Pk + ((size_t)b * SEQA + pos) * PKW + 512 + c0 + kc * 8);
    *(uint4*)(xr + t * 64 + kc * 8) = v;
  }
  __syncthreads();
  {
    const int ch = tid & 63;
    const float* cw = p.cw + (size_t)l * 4 * 256 + c0 + ch;
    const float w0 = cw[0], w1 = cw[256], w2 = cw[512], w3 = cw[768], bias = p.cb[l * 256 + c0 + ch];
#pragma unroll 4
    for (int e = 0; e < 16; e++) {
      const int t = (tid >> 6) + 4 * e;
      float v = w0 * bf2f(xr[t * 64 + ch]) + w1 * bf2f(xr[(t + 1) * 64 + ch]) + w2 * bf2f(xr[(t + 2) * 64 + ch]) + w3 * bf2f(xr[(t + 3) * 64 + ch]) + bias;
      xcb[t][ch] = f2bf(v);
    }
  }
  __syncthreads();
  {
    const int tb = w & 1, ob = w >> 1;
    const int chn = ob * 32 + r;
#pragma unroll
    for (int dir = 0; dir < 2; dir++) {
      f32x16 ga, gx;
#pragma unroll
      for (int i = 0; i < 16; i++) { ga[i] = 0.f; gx[i] = 0.f; }
      const u16* wa = p.WtA + (((size_t)l * 2 + dir) * 4 + blk) * 4096 + (size_t)chn * 64 + h * 8;
      const u16* wx = p.WtX + (((size_t)l * 2 + dir) * 4 + blk) * 4096 + (size_t)chn * 64 + h * 8;
#pragma unroll
      for (int ks = 0; ks < 4; ks++) {
        bf16x8 a = *(const bf16x8*)&xcb[tb * 32 + r][ks * 16 + h * 8];
        bf16x8 ba = *(const bf16x8*)(wa + ks * 16), bx = *(const bf16x8*)(wx + ks * 16);
        ga = MFMA(a, ba, ga); gx = MFMA(a, bx, gx);
      }
      const int pi = (l * 2 + dir) * 256 + c0 + chn;
      const float b_a = p.ba[pi], b_x = p.bx[pi], lam = p.lam[pi];
      const float sp = log1pf(__expf(-lam));
#pragma unroll
      for (int i = 0; i < 16; i++) {
        const int tok = tb * 32 + crow(i, h);
        const float rr = __builtin_amdgcn_rcpf(1.f + __expf(-(ga[i] + b_a))), ii = __builtin_amdgcn_rcpf(1.f + __expf(-(gx[i] + b_x)));
        const float la = -8.f * rr * sp;
        const float a = __expf(la);
        const float x2 = 2.f * la;
        const float ser = -x2 * (1.f + x2 * (0.5f + x2 * (0.16666667f + x2 * (0.041666668f + x2 * 0.0083333338f))));
        const float om = (x2 > -0.25f) ? ser : (1.f - a * a);
        const float u = __builtin_amdgcn_sqrtf(fmaxf(om, 0.f)) * ii * bf2f(xcb[tok][chn]);
        au[(dir * 64 + tok) * 64 + chn] = make_float2(a, u);
      }
    }
  }
  __syncthreads();
  float2* agg = (float2*)p.agg;
  if (w < 2) {
    const int dir = w, ch = lane;
    float hst = 0.f;
    if (!fin) {
      float Ap = 1.f;
#pragma unroll 8
      for (int s2 = 0; s2 < 64; s2++) { const int t = dir ? 63 - s2 : s2; float2 v = au[(dir * 64 + t) * 64 + ch]; hst = v.x * hst + v.y; Ap *= v.x; }
      agg[(((size_t)b * 68 + chunk) * 2 + dir) * 256 + c0 + ch] = make_float2(Ap, hst);
    } else {
      const float2* ag = agg + ((size_t)b * 68 * 2 + dir) * 256 + c0 + ch;
      if (dir == 0) {
#pragma unroll 8
        for (int cc = 0; cc < chunk; cc++) { float2 v = ag[(size_t)cc * 512]; hst = v.x * hst + v.y; }
      } else {
        if (chunk < 4) { for (int cc = 3; cc > chunk; cc--) { float2 v = ag[(size_t)cc * 512]; hst = v.x * hst + v.y; } }
        else {
          for (int cc = 3; cc >= 0; cc--) { float2 v = ag[(size_t)cc * 512]; hst = v.x * hst + v.y; }
#pragma unroll 8
          for (int cc = 67; cc > chunk; cc--) { float2 v = ag[(size_t)cc * 512]; hst = v.x * hst + v.y; }
        }
      }
#pragma unroll 8
      for (int s2 = 0; s2 < 64; s2++) { const int t = dir ? 63 - s2 : s2; float2 v = au[(dir * 64 + t) * 64 + ch]; hst = v.x * hst + v.y; au[(dir * 64 + t) * 64 + ch].y = hst; }
    }
  }
  if (fin) {
    __syncthreads();
    const int ch4 = (tid & 15) * 4;
#pragma unroll
    for (int ps = 0; ps < 4; ps++) {
      const int t = (tid >> 4) + 16 * ps;
      const size_t row = (size_t)b * SEQA + pos0 + t;
      uint2 zz = *(const uint2*)(p.Pk + row * PKW + 768 + 512 + c0 + ch4);
      float y0 = au[(t) * 64 + ch4].y + au[(64 + t) * 64 + ch4].y, y1 = au[(t) * 64 + ch4 + 1].y + au[(64 + t) * 64 + ch4 + 1].y;
      float y2 = au[(t) * 64 + ch4 + 2].y + au[(64 + t) * 64 + ch4 + 2].y, y3 = au[(t) * 64 + ch4 + 3].y + au[(64 + t) * 64 + ch4 + 3].y;
      uint2 o; o.x = pack2(y0 * silu(bflo(zz.x)), y1 * silu(bfhi(zz.x))); o.y = pack2(y2 * silu(bflo(zz.y)), y3 * silu(bfhi(zz.y)));
      *(uint2*)(p.G + row * 1024 + 512 + c0 + ch4) = o;
    }
  }
}

DI void rope32(float (&y)[64], int base, const float* tab  , int pr) {
#pragma unroll
  for (int d = 0; d < 16; d++) {
    float2 cs = *(const float2*)(tab + (pr * 16 + d) * 2);
    float a = y[base + d], b = y[base + 16 + d];
    y[base + d] = a * cs.x - b * cs.y; y[base + 16 + d] = b * cs.x + a * cs.y;
  }
}

DI void gqa_head(const Params& p, int l, int row, const u16* src, const float* g, u16* dst, float mul) {
  const int pos = row % SEQA;
  float y[64];
  float ss = 0.f;
#pragma unroll
  for (int j = 0; j < 8; j++) {
    uint4 v = *(const uint4*)(src + j * 8);
    y[8 * j] = bflo(v.x); y[8 * j + 1] = bfhi(v.x); y[8 * j + 2] = bflo(v.y); y[8 * j + 3] = bfhi(v.y);
    y[8 * j + 4] = bflo(v.z); y[8 * j + 5] = bfhi(v.z); y[8 * j + 6] = bflo(v.w); y[8 * j + 7] = bfhi(v.w);
  }
#pragma unroll
  for (int d = 0; d < 64; d++) ss += y[d] * y[d];
  const float rinv = rsqrtf(ss * (1.f / 64.f) + EPS) * mul;
#pragma unroll
  for (int d = 0; d < 64; d++) y[d] = y[d] * rinv * g[d];
  if (pos >= CTXL) { const int t = pos - CTXL; rope32(y, 0, p.ropeD, t >> 6); rope32(y, 32, p.ropeD, t & 63); }
#pragma unroll
  for (int j = 0; j < 8; j++) {
    uint4 o; o.x = pack2(y[8 * j], y[8 * j + 1]); o.y = pack2(y[8 * j + 2], y[8 * j + 3]); o.z = pack2(y[8 * j + 4], y[8 * j + 5]); o.w = pack2(y[8 * j + 6], y[8 * j + 7]);
    *(uint4*)(dst + j * 8) = o;
  }
}

DI void prep_item(const Params& p, int l, int mt, int tid) {
  const int m0 = mt * 128;
  for (int e = tid; e < 512; e += 256) {
    const int row = m0 + (e >> 2), hd = e & 3;
    gqa_head(p, l, row, p.Pt + (size_t)row * PTW + 416 + hd * 64, p.gqn + l * 64, p.QD + (size_t)row * 256 + hd * 64, 0.125f * LOG2E);
  }
  {
    const int row = m0 + (tid >> 1), hk = tid & 1; const int b = row / SEQA, pos = row % SEQA;
    gqa_head(p, l, row, p.Pt + (size_t)row * PTW + 672 + hk * 64, p.gkn + l * 64, p.KD + (((size_t)b * 2 + hk) * SEQA + pos) * 64, 1.f);
  }
  if (tid < 128) {
    const int row = m0 + tid; const int b = row / SEQA, pos = row % SEQA;
    const u16* src = p.Pt + (size_t)row * PTW + 384;
    float y[32];
#pragma unroll
    for (int j = 0; j < 4; j++) {
      uint4 v = *(const uint4*)(src + j * 8);
      y[8 * j] = bflo(v.x); y[8 * j + 1] = bfhi(v.x); y[8 * j + 2] = bflo(v.y); y[8 * j + 3] = bfhi(v.y);
      y[8 * j + 4] = bflo(v.z); y[8 * j + 5] = bfhi(v.z); y[8 * j + 6] = bflo(v.w); y[8 * j + 7] = bfhi(v.w);
    }
    if (pos >= CTXL) {
      const int t = pos - CTXL;
#pragma unroll
      for (int hf = 0; hf < 2; hf++) {
        const int pr = hf ? (t & 63) : (t >> 6);
#pragma unroll
        for (int d = 0; d < 8; d++) {
          float2 cs = *(const float2*)(p.ropeB + (pr * 8 + d) * 2);
          float a = y[16 * hf + d], bq = y[16 * hf + 8 + d];
          y[16 * hf + d] = a * cs.x - bq * cs.y; y[16 * hf + 8 + d] = bq * cs.x + a * cs.y;
        }
      }
    }
#pragma unroll
    for (int hd = 0; hd < 4; hd++) {
      u16* dst = p.KB + (((size_t)b * 4 + hd) * SEQA + pos) * 96 + 64;
#pragma unroll
      for (int j = 0; j < 4; j++) {
        uint4 o; o.x = pack2(y[8 * j], y[8 * j + 1]); o.y = pack2(y[8 * j + 2], y[8 * j + 3]); o.z = pack2(y[8 * j + 4], y[8 * j + 5]); o.w = pack2(y[8 * j + 6], y[8 * j + 7]);
        *(uint4*)(dst + j * 8) = o;
      }
    }
  }
}

DI void phase_prep(const Params& p, int l, char* smem, int tid) {
  const int lane = tid & 63, w = tid >> 6, r = lane & 31, h = lane >> 5, wm = w >> 1, wn = w & 1;
  GemmLds* s = (GemmLds*)smem;
  float* rs = (float*)(smem + sizeof(GemmLds));
  const int NQ = 272 * 3, NKV = 272 * 4, NPR = 272, NLRU = 8 * 68 * 4;
  const int G = gridDim.x;
  int start = blockIdx.x;
  for (int it = start; it < NQ; it += G) {
      const int mt = it / 3, nt = it % 3, m0 = mt * 128, n0 = nt * 128;
      const u16* A = p.Pt + (size_t)m0 * PTW;
      __syncthreads();
      row_rs(A, PTW, 256, rs, tid);
      f32x16 acc[2][2]; zero_acc<2>(acc);
      gemm_main<2>(A, PTW, p.WtUq + (size_t)l * 384 * 256 + (size_t)n0 * 256, 256, 256, acc, s, tid);
#pragma unroll
      for (int mb = 0; mb < 2; mb++)
#pragma unroll
        for (int nb = 0; nb < 2; nb++) {
          const int rl = wm * 64 + mb * 32, rowb = m0 + rl, colb = n0 + wn * 64 + nb * 32, col = colb + r;
          const int pos0 = rowb % SEQA;
          const bool rope = ((colb >> 5) % 3 == 2) && (pos0 >= CTXL);
#pragma unroll
          for (int i = 0; i < 16; i++) {
            const int ro = crow(i, h);
            float v = acc[mb][nb][i] * rs[rl + ro];
            if (rope) {
              const float pv = dpp_mov<0x128>(v);
              const int t = pos0 + ro - CTXL; const int pr = (r & 16) ? (t & 63) : (t >> 6);
              float2 cs = *(const float2*)(p.ropeB + (pr * 8 + (r & 7)) * 2);
              v = v * cs.x + ((r & 8) ? pv : -pv) * cs.y;
            }
            p.QB[(size_t)(rowb + ro) * 384 + col] = f2bf(v * (0.10206207261596577f * LOG2E));
          }
        }
  }
  start = (start + G - NQ % G) % G;
  for (int j = start; j < NKV; j += G) {
      const int mt = j >> 2, nt = j & 3, m0 = mt * 128, n0 = nt * 128;
      const u16* A = p.Pt + (size_t)m0 * PTW + 256;
      __syncthreads();
      row_rs(A, PTW, 128, rs, tid);
      f32x16 acc[2][2]; zero_acc<2>(acc);
      gemm_main<2>(A, PTW, p.WtUkv + (size_t)l * 512 * 128 + (size_t)n0 * 128, 128, 128, acc, s, tid);
#pragma unroll
      for (int mb = 0; mb < 2; mb++)
#pragma unroll
        for (int nb = 0; nb < 2; nb++) {
          const int rl = wm * 64 + mb * 32, rowb = m0 + rl, colb = n0 + wn * 64 + nb * 32, col = colb + r;
          const int b = rowb / SEQA, pos0 = rowb % SEQA, hd = col >> 7, wc = col & 127;
          if (wc < 64) {
            u16* dst = p.KB + (((size_t)b * 4 + hd) * SEQA + pos0) * 96 + wc;
#pragma unroll
            for (int i = 0; i < 16; i++) { const int ro = crow(i, h); dst[(size_t)ro * 96] = f2bf(acc[mb][nb][i] * rs[rl + ro]); }
          } else {
            u16* dst = p.VtB + (((size_t)b * 4 + hd) * 64 + (wc - 64)) * SEQA + pos0;
#pragma unroll
            for (int g = 0; g < 4; g++) {
              const int ro = 8 * g + 4 * h;
              uint2 o; o.x = pack2(acc[mb][nb][4 * g] * rs[rl + ro], acc[mb][nb][4 * g + 1] * rs[rl + ro + 1]);
              o.y = pack2(acc[mb][nb][4 * g + 2] * rs[rl + ro + 2], acc[mb][nb][4 * g + 3] * rs[rl + ro + 3]);
              *(uint2*)(dst + ro) = o;
            }
          }
        }
  }
  start = (start + G - NKV % G) % G;
  for (int j = start; j < NPR; j += G) prep_item(p, l, j, tid);
  start = (start + G - NPR % G) % G;
  for (int j = start; j < NLRU; j += G) {
      const int blk = j & 3, chunk = (j >> 2) % 68, b = (j >> 2) / 68;
      lru_item(p, l, b, chunk, blk, false, smem, tid);
  }
}

template <int DK, bool NA>
DI void attn_item(const u16* __restrict__ Q, int ldq, const u16* __restrict__ K, int ldk, const u16* __restrict__ Vt, int nTiles, float sc,
                  int nWin, int rsA, int pr, const float* __restrict__ relb_h, u16* __restrict__ Gp, const u16* __restrict__ Zp, char* smem, int tid) {
  constexpr int KS = DK / 16, LK = DK + 8, KCH = DK / 8, NKC = (64 * KCH) / 256;
  u16 (*Ks)[64][LK] = (u16(*)[64][LK])smem;
  u16 (*Vs)[64][72] = (u16(*)[64][72])(smem + 2 * 64 * LK * 2);
  float* biasL = (float*)(smem + 2 * 64 * LK * 2 + 2 * 64 * 72 * 2);
  const int lane = tid & 63, w = tid >> 6, r = lane & 31, h = lane >> 5;
  __syncthreads();
  if (NA) { for (int i = tid; i < 465; i += 256) biasL[i] = relb_h[i] * LOG2E; }
  bf16x8 qf[KS];
  {
    const u16* qrow = Q + (size_t)(w * 32 + r) * ldq + h * 8;
#pragma unroll
    for (int ks = 0; ks < KS; ks++) qf[ks] = *(const bf16x8*)(qrow + ks * 16);
  }
  const int iw = 2 * pr + (w >> 1), rsw = clampi(iw - 4, 0, 56), jq = 32 * (w & 1) + r, cs = clampi(jq - 8, 0, 48);
  f32x16 o[2];
#pragma unroll
  for (int i = 0; i < 16; i++) { o[0][i] = 0.f; o[1][i] = 0.f; }
  float m_run = -1e30f, l_run = 0.f;
  uint4 rk0, rk1, rk2, rv0, rv1;
  rk2 = make_uint4(0, 0, 0, 0);
  const int kr0 = tid / KCH, kc0 = (tid % KCH) * 8, kr1 = (tid + 256) / KCH, kc1 = ((tid + 256) % KCH) * 8, kr2 = (tid + 512) / KCH, kc2 = ((tid + 512) % KCH) * 8;
  const int vd0 = tid >> 3, vk0 = (tid & 7) * 8;
#define TILE_POS(t) (NA ? ((t) < nWin ? CTXL + (rsA + (t)) * 64 : ((t) - nWin) * 64) : (t) * 64)
#define GLOAD(t) { const int pos0_ = TILE_POS(t); \
    rk0 = *(const uint4*)(K + (size_t)(pos0_ + kr0) * ldk + kc0); rk1 = *(const uint4*)(K + (size_t)(pos0_ + kr1) * ldk + kc1); \
    if (NKC == 3) rk2 = *(const uint4*)(K + (size_t)(pos0_ + kr2) * ldk + kc2); \
    rv0 = *(const uint4*)(Vt + (size_t)vd0 * SEQA + pos0_ + vk0); rv1 = *(const uint4*)(Vt + (size_t)(vd0 + 32) * SEQA + pos0_ + vk0); }
#define LSTORE(bf) { *(uint4*)&Ks[bf][kr0][kc0] = rk0; *(uint4*)&Ks[bf][kr1][kc1] = rk1; if (NKC == 3) *(uint4*)&Ks[bf][kr2][kc2] = rk2; \
    *(uint4*)&Vs[bf][vd0][vk0] = rv0; *(uint4*)&Vs[bf][vd0 + 32][vk0] = rv1; }
  GLOAD(0); LSTORE(0);
  __syncthreads();
  for (int t = 0; t < nTiles; t++) {
    const int buf = t & 1;
    if (t + 1 < nTiles) GLOAD(t + 1);
    const bool win = NA && (t < nWin);
    const int kr = rsA + t;
    bool act = true;
    if (win) act = (kr >= rsw) && (kr < rsw + 8);
    if (act) {
      f32x16 s[2];
#pragma unroll
      for (int kb = 0; kb < 2; kb++) {
#pragma unroll
        for (int i = 0; i < 16; i++) s[kb][i] = 0.f;
#pragma unroll
        for (int ks = 0; ks < KS; ks++) { bf16x8 a = *(const bf16x8*)&Ks[buf][kb * 32 + r][ks * 16 + h * 8]; s[kb] = MFMA(a, qf[ks], s[kb]); }
      }
      float mx = -1e30f;
#pragma unroll
      for (int kb = 0; kb < 2; kb++)
#pragma unroll
        for (int i = 0; i < 16; i++) {
          float v = s[kb][i];
          if (NA) {
            if (win) {
              const int kc = kb * 32 + (i & 3) + 8 * (i >> 2) + 4 * h;
              const bool vis = (unsigned)(kc - cs) < 16u;
              const int idx = (kr - iw + 7) * 31 + (kc - jq + 15);
              const float bv = biasL[vis ? idx : 0];
              v = vis ? v + bv : -1e30f;
            }
          }
          s[kb][i] = v; mx = fmaxf(mx, v);
        }
      mx = xhalf_max(mx);
      float mn = m_run;
      if (__builtin_amdgcn_ballot_w64(mx > m_run) != 0) {
        mn = fmaxf(m_run, mx);
        const float al = __builtin_amdgcn_exp2f(m_run - mn);
        m_run = mn; l_run *= al;
#pragma unroll
        for (int i = 0; i < 16; i++) { o[0][i] *= al; o[1][i] *= al; }
      }
      float ls = 0.f;
#pragma unroll
      for (int kb = 0; kb < 2; kb++)
#pragma unroll
        for (int i = 0; i < 16; i++) { float pv = __builtin_amdgcn_exp2f(s[kb][i] - mn); s[kb][i] = pv; ls += pv; }
      l_run += ls;
      bf16x8 pf[2][2];
#pragma unroll
      for (int kb = 0; kb < 2; kb++)
#pragma unroll
        for (int sx = 0; sx < 2; sx++) {
          uint4 u; u.x = pack2(s[kb][8 * sx], s[kb][8 * sx + 1]); u.y = pack2(s[kb][8 * sx + 2], s[kb][8 * sx + 3]);
          u.z = pack2(s[kb][8 * sx + 4], s[kb][8 * sx + 5]); u.w = pack2(s[kb][8 * sx + 6], s[kb][8 * sx + 7]);
          pf[kb][sx] = __builtin_bit_cast(bf16x8, u);
        }
#pragma unroll
      for (int db = 0; db < 2; db++)
#pragma unroll
        for (int kb = 0; kb < 2; kb++)
#pragma unroll
          for (int sx = 0; sx < 2; sx++) {
            const u16* vp = &Vs[buf][db * 32 + r][32 * kb + 16 * sx + 4 * h];
            uint2 lo = *(const uint2*)vp, hi = *(const uint2*)(vp + 8);
            uint4 u; u.x = lo.x; u.y = lo.y; u.z = hi.x; u.w = hi.y;
            o[db] = MFMA(__builtin_bit_cast(bf16x8, u), pf[kb][sx], o[db]);
          }
    }
    if (t + 1 < nTiles) LSTORE(buf ^ 1);
    __syncthreads();
  }
#undef TILE_POS
#undef GLOAD
#undef LSTORE
  const float lt = xhalf_sum(l_run);
  const float inv = __builtin_amdgcn_rcpf(lt);
  const int q = w * 32 + r;
#pragma unroll
  for (int db = 0; db < 2; db++)
#pragma unroll
    for (int g = 0; g < 4; g++) {
      const int d0 = 32 * db + 8 * g + 4 * h;
      uint2 zz = *(const uint2*)(Zp + (size_t)q * PKW + d0);
      uint2 ov; ov.x = pack2(o[db][4 * g] * inv * silu(bflo(zz.x)), o[db][4 * g + 1] * inv * silu(bfhi(zz.x)));
      ov.y = pack2(o[db][4 * g + 2] * inv * silu(bflo(zz.y)), o[db][4 * g + 3] * inv * silu(bfhi(zz.y)));
      *(uint2*)(Gp + (size_t)q * 1024 + d0) = ov;
    }
}

template <int DK>
DI void attn_item2(const u16* __restrict__ Q, int ldq, const u16* __restrict__ K, int ldk, const u16* __restrict__ Vt, int nTiles,
                   u16* __restrict__ Gp, const u16* __restrict__ Zp, char* smem, int tid) {
  constexpr int KS = DK / 16, LK = DK + 8, KCH = DK / 8, NKC = (64 * KCH) / 256;
  u16 (*Ks)[64][LK] = (u16(*)[64][LK])smem;
  u16 (*Vs)[64][72] = (u16(*)[64][72])(smem + 2 * 64 * LK * 2);
  const int lane = tid & 63, w = tid >> 6, r = lane & 31, h = lane >> 5;
  __syncthreads();
  bf16x8 qf[2][KS];
#pragma unroll
  for (int qw = 0; qw < 2; qw++) {
    const u16* qrow = Q + (size_t)((w * 2 + qw) * 32 + r) * ldq + h * 8;
#pragma unroll
    for (int ks = 0; ks < KS; ks++) qf[qw][ks] = *(const bf16x8*)(qrow + ks * 16);
  }
  f32x16 o[2][2];
#pragma unroll
  for (int i = 0; i < 16; i++) { o[0][0][i] = 0.f; o[0][1][i] = 0.f; o[1][0][i] = 0.f; o[1][1][i] = 0.f; }
  float m_run0 = -1e30f, m_run1 = -1e30f, l_run0 = 0.f, l_run1 = 0.f;
  uint4 rk0, rk1, rk2, rv0, rv1;
  rk2 = make_uint4(0, 0, 0, 0);
  const int kr0 = tid / KCH, kc0 = (tid % KCH) * 8, kr1 = (tid + 256) / KCH, kc1 = ((tid + 256) % KCH) * 8, kr2 = (tid + 512) / KCH, kc2 = ((tid + 512) % KCH) * 8;
  const int vd0 = tid >> 3, vk0 = (tid & 7) * 8;
#define GLOAD(t) { const int pos0_ = (t) * 64; \
    rk0 = *(const uint4*)(K + (size_t)(pos0_ + kr0) * ldk + kc0); rk1 = *(const uint4*)(K + (size_t)(pos0_ + kr1) * ldk + kc1); \
    if (NKC == 3) rk2 = *(const uint4*)(K + (size_t)(pos0_ + kr2) * ldk + kc2); \
    rv0 = *(const uint4*)(Vt + (size_t)vd0 * SEQA + pos0_ + vk0); rv1 = *(const uint4*)(Vt + (size_t)(vd0 + 32) * SEQA + pos0_ + vk0); }
#define LSTORE(bf) { *(uint4*)&Ks[bf][kr0][kc0] = rk0; *(uint4*)&Ks[bf][kr1][kc1] = rk1; if (NKC == 3) *(uint4*)&Ks[bf][kr2][kc2] = rk2; \
    *(uint4*)&Vs[bf][vd0][vk0] = rv0; *(uint4*)&Vs[bf][vd0 + 32][vk0] = rv1; }
  GLOAD(0); LSTORE(0);
  __syncthreads();
  for (int t = 0; t < nTiles; t++) {
    const int buf = t & 1;
    if (t + 1 < nTiles) GLOAD(t + 1);
#pragma unroll
    for (int kb = 0; kb < 2; kb++) {
      f32x16 s0, s1;
#pragma unroll
      for (int i = 0; i < 16; i++) { s0[i] = 0.f; s1[i] = 0.f; }
#pragma unroll
      for (int ks = 0; ks < KS; ks++) {
        bf16x8 a = *(const bf16x8*)&Ks[buf][kb * 32 + r][ks * 16 + h * 8];
        s0 = MFMA(a, qf[0][ks], s0);
        s1 = MFMA(a, qf[1][ks], s1);
      }
      bf16x8 pf0[2], pf1[2];
#define SOFTMAX_STEP(S, M, L, O, PF) { \
        float mx = fmaxf(fmaxf(fmaxf(S[0], S[1]), fmaxf(S[2], S[3])), fmaxf(fmaxf(S[4], S[5]), fmaxf(S[6], S[7]))); \
        mx = fmaxf(mx, fmaxf(fmaxf(fmaxf(S[8], S[9]), fmaxf(S[10], S[11])), fmaxf(fmaxf(S[12], S[13]), fmaxf(S[14], S[15])))); \
        mx = xhalf_max(mx); \
        if (__builtin_amdgcn_ballot_w64(mx > M) != 0) {     \
          const float mn_ = fmaxf(M, mx); const float al_ = __builtin_amdgcn_exp2f(M - mn_); M = mn_; L *= al_; \
          _Pragma("unroll") for (int i = 0; i < 16; i++) { O[0][i] *= al_; O[1][i] *= al_; } \
        } \
        float ls_ = 0.f; \
        _Pragma("unroll") for (int i = 0; i < 16; i++) { float pv_ = __builtin_amdgcn_exp2f(S[i] - M); S[i] = pv_; ls_ += pv_; } \
        L += ls_; \
        _Pragma("unroll") for (int sx = 0; sx < 2; sx++) { uint4 u_; u_.x = pack2(S[8 * sx], S[8 * sx + 1]); u_.y = pack2(S[8 * sx + 2], S[8 * sx + 3]); \
          u_.z = pack2(S[8 * sx + 4], S[8 * sx + 5]); u_.w = pack2(S[8 * sx + 6], S[8 * sx + 7]); PF[sx] = __builtin_bit_cast(bf16x8, u_); } }
      SOFTMAX_STEP(s0, m_run0, l_run0, o[0], pf0)
      SOFTMAX_STEP(s1, m_run1, l_run1, o[1], pf1)
#undef SOFTMAX_STEP
#pragma unroll
      for (int db = 0; db < 2; db++)
#pragma unroll
        for (int sx = 0; sx < 2; sx++) {
          const u16* vp = &Vs[buf][db * 32 + r][32 * kb + 16 * sx + 4 * h];
          uint2 lo = *(const uint2*)vp, hi = *(const uint2*)(vp + 8);
          uint4 u; u.x = lo.x; u.y = lo.y; u.z = hi.x; u.w = hi.y;
          const bf16x8 a = __builtin_bit_cast(bf16x8, u);
          o[0][db] = MFMA(a, pf0[sx], o[0][db]);
          o[1][db] = MFMA(a, pf1[sx], o[1][db]);
        }
    }
    if (t + 1 < nTiles) LSTORE(buf ^ 1);
    __syncthreads();
  }
#undef GLOAD
#undef LSTORE
#pragma unroll
  for (int qw = 0; qw < 2; qw++) {
    const float inv = __builtin_amdgcn_rcpf(xhalf_sum(qw ? l_run1 : l_run0));
    const int q = (w * 2 + qw) * 32 + r;
#pragma unroll
    for (int db = 0; db < 2; db++)
#pragma unroll
      for (int g = 0; g < 4; g++) {
        const int d0 = 32 * db + 8 * g + 4 * h;
        uint2 zz = *(const uint2*)(Zp + (size_t)q * PKW + d0);
        uint2 ov; ov.x = pack2(o[qw][db][4 * g] * inv * silu(bflo(zz.x)), o[qw][db][4 * g + 1] * inv * silu(bfhi(zz.x)));
        ov.y = pack2(o[qw][db][4 * g + 2] * inv * silu(bflo(zz.y)), o[qw][db][4 * g + 3] * inv * silu(bfhi(zz.y)));
        *(uint2*)(Gp + (size_t)q * 1024 + d0) = ov;
      }
  }
}

DI int fetch_item(unsigned* ctr, char* smem) {
  volatile int* slot = (volatile int*)(smem + SMEM_BYTES - 16);
  __syncthreads();
  if (threadIdx.x == 0) *slot = (int)__hip_atomic_fetch_add(ctr, 1u, __ATOMIC_RELAXED, __HIP_MEMORY_SCOPE_AGENT);
  __syncthreads();
  return *slot;
}

DI void phase_mix(const Params& p, int l, char* smem, int tid) {
  const bool need_ctx = (l == 0);
  const int NL = 1024, NC = need_ctx ? 64 : 0;
  const int NL2 = 512, NC2 = need_ctx ? 32 : 0, NT2 = NL2 + NC2;
  const int NLRU = need_ctx ? 8 * 68 * 4 : 8 * 64 * 4;
  const float scD = 0.125f * LOG2E;
  unsigned* q = p.bar + 4096 + l * 512;
#define DECODE2(it) int b, hd; size_t q0; int nT; \
    if ((it) < NL2) { b = (it) >> 6; hd = ((it) >> 4) & 3; q0 = (size_t)b * SEQA + CTXL + ((it) & 15) * 256; nT = 68; } \
    else { int j_ = (it) - NL2; b = j_ >> 2; hd = j_ & 3; q0 = (size_t)b * SEQA; nT = 4; }
#define DECODE_ITEM(it) int b, hd, qb; bool isctx; \
    if ((it) < NL) { b = (it) >> 7; hd = ((it) >> 5) & 3; qb = (it) & 31; isctx = false; } \
    else { int j_ = (it) - NL; b = j_ >> 3; hd = (j_ >> 1) & 3; qb = j_ & 1; isctx = true; } \
    const size_t q0 = (size_t)b * SEQA + (isctx ? 0 : CTXL) + qb * 128; const int nT = isctx ? 4 : 68;
  for (int it = fetch_item(q, smem); it < NT2; it = fetch_item(q, smem)) {
    DECODE2(it)
    const int hk = hd >> 1;
    attn_item2<64>(p.QD + q0 * 256 + hd * 64, 256, p.KD + ((size_t)b * 2 + hk) * SEQA * 64, 64, p.VtAD + ((size_t)b * 384 + 256 + hk * 64) * SEQA, nT,
                   p.G + q0 * 1024 + 768 + hd * 64, p.Pk + q0 * PKW + 768 + 768 + hd * 64, smem, tid);
  }
#undef DECODE2
  for (int it = fetch_item(q + 64, smem); it < NL + NC; it = fetch_item(q + 64, smem)) {
    DECODE_ITEM(it)
    attn_item<96, false>(p.QB + q0 * 384 + hd * 96, 384, p.KB + ((size_t)b * 4 + hd) * SEQA * 96, 96, p.VtB + ((size_t)b * 4 + hd) * 64 * SEQA, nT, 1.f,
                         0, 0, 0, nullptr, p.G + q0 * 1024 + 256 + hd * 64, p.Pk + q0 * PKW + 768 + 256 + hd * 64, smem, tid);
  }
  for (int it = fetch_item(q + 128, smem); it < NL; it = fetch_item(q + 128, smem)) {
    DECODE_ITEM(it)
    (void)isctx; (void)nT;
    const int rsA = clampi(2 * qb - 4, 0, 56), rsB = clampi(2 * qb + 1 - 4, 0, 56), nWin = rsB - rsA + 8;
    attn_item<64, true>(p.Pk + q0 * PKW + hd * 64, PKW, p.Pk + (size_t)b * SEQA * PKW + 256 + hd * 64, PKW, p.VtAD + ((size_t)b * 384 + hd * 64) * SEQA, nWin + 4, scD,
                        nWin, rsA, qb, p.relb + ((size_t)l * 4 + hd) * 465, p.G + q0 * 1024 + hd * 64, p.Pk + q0 * PKW + 768 + hd * 64, smem, tid);
  }
  for (int j = fetch_item(q + 192, smem); j < NC; j = fetch_item(q + 192, smem)) {
    const int it = NL + j;
    DECODE_ITEM(it)
    attn_item<64, false>(p.Pk + q0 * PKW + hd * 64, PKW, p.Pk + (size_t)b * SEQA * PKW + 256 + hd * 64, PKW, p.VtAD + ((size_t)b * 384 + hd * 64) * SEQA, nT, scD,
                         0, 0, 0, nullptr, p.G + q0 * 1024 + hd * 64, p.Pk + q0 * PKW + 768 + hd * 64, smem, tid);
  }
#undef DECODE_ITEM
  for (int j = fetch_item(q + 256, smem); j < NLRU; j = fetch_item(q + 256, smem)) {
    const int blk = j & 3;
    int chunk, b;
    if (need_ctx) { chunk = (j >> 2) % 68; b = (j >> 2) / 68; } else { chunk = 4 + ((j >> 2) & 63); b = (j >> 2) >> 6; }
    lru_item(p, l, b, chunk, blk, true, smem, tid);
  }
}

DI void phase_merge(const Params& p, int l, char* smem, int tid) {
  const int lane = tid & 63, w = tid >> 6, r = lane & 31, h = lane >> 5, wm = w >> 1, wn = w & 1;
  GemmLds* s = (GemmLds*)smem;
  u16* ACC = p.Pk;
  const bool dyn = (l == 0);
  unsigned* qc = p.bar + 4096 + 320;
  for (int it = (dyn ? fetch_item(qc, smem) : (int)blockIdx.x); it < 544 * 8; it = (dyn ? fetch_item(qc, smem) : it + (int)gridDim.x)) {
    const int mt = it >> 3, nt = it & 7, m0 = mt * 64, n0 = nt * 128;
    if (l == 1 && (mt % 68) < 4) continue;
    f32x16 accT[1][2]; zero_acc<1>(accT);
#pragma unroll 1
    for (int i = 0; i < 4; i++) {
      if ((ZERO_MASK >> i) & 1) continue;
      unsigned sg[2][8];
      {
        f32x16 m[1][2]; zero_acc<1>(m);
        gemm_main<1>(p.xn + (size_t)m0 * 1024, 1024, p.WtM + (size_t)l * 4096 * 1024 + ((size_t)i * 1024 + n0) * 1024, 1024, 1024, m, s, tid);
#pragma unroll
        for (int b2 = 0; b2 < 2; b2++)
#pragma unroll
          for (int e = 0; e < 8; e++) sg[b2][e] = pack2(sigm_fast(m[0][b2][2 * e]), sigm_fast(m[0][b2][2 * e + 1]));
      }
      f32x16 t[1][2]; zero_acc<1>(t);
      gemm_main<1>(p.G + (size_t)m0 * 1024 + i * 256, 1024, p.WtBr + ((size_t)l * 4 + i) * 1024 * 256 + (size_t)n0 * 256, 256, 256, t, s, tid);
#pragma unroll
      for (int b2 = 0; b2 < 2; b2++)
#pragma unroll
        for (int e = 0; e < 8; e++) { accT[0][b2][2 * e] += bflo(sg[b2][e]) * t[0][b2][2 * e]; accT[0][b2][2 * e + 1] += bfhi(sg[b2][e]) * t[0][b2][2 * e + 1]; }
    }
#pragma unroll
    for (int nb = 0; nb < 2; nb++) {
      const int rowb = m0 + wm * 32, col = n0 + wn * 64 + nb * 32 + r;
#pragma unroll
      for (int i = 0; i < 16; i++) ACC[(size_t)(rowb + crow(i, h)) * 1024 + col] = f2bf(accT[0][nb][i]);
    }
  }
}

DI void phase_outproj(const Params& p, int l, char* smem, int tid) {
  const int lane = tid & 63, w = tid >> 6, r = lane & 31, h = lane >> 5, wm = w >> 1, wn = w & 1;
  GemmLds* s = (GemmLds*)smem;
  const u16* ACC = p.Pk;
  const bool dyn = (l == 0);
  unsigned* qc = p.bar + 4096 + 384;
  for (int it = (dyn ? fetch_item(qc, smem) : (int)blockIdx.x); it < 272 * 8; it = (dyn ? fetch_item(qc, smem) : it + (int)gridDim.x)) {
    const int mt = it >> 3, nt = it & 7, m0 = mt * 128, n0 = nt * 128;
    if (l == 1 && (mt % 34) < 2) continue;
    f32x16 acc[2][2]; zero_acc<2>(acc);
    gemm_main<2>(ACC + (size_t)m0 * 1024, 1024, p.WtOut + (size_t)l * 1024 * 1024 + (size_t)n0 * 1024, 1024, 1024, acc, s, tid);
    u16* O = p.G;
#pragma unroll
    for (int mb = 0; mb < 2; mb++)
#pragma unroll
      for (int nb = 0; nb < 2; nb++) {
        const int rowb = m0 + wm * 64 + mb * 32, col = n0 + wn * 64 + nb * 32 + r;
        const int b = rowb / SEQA, pos0 = rowb % SEQA;
        const float gate = p.mod[((size_t)l * 9 + ((pos0 < CTXL) ? 8 : b)) * 3072 + 2048 + col];
#pragma unroll
        for (int i = 0; i < 16; i++) O[(size_t)(rowb + crow(i, h)) * 1024 + col] = f2bf(gate * acc[mb][nb][i]);
      }
  }
}

#if MULTI
DI void run_phase(const Params& p, int ph, char* smem, int tid) {
  if (ph == 0) { phase0(p, smem, tid); return; }
  if (ph == 1) { phase_ln0(p, tid); return; }
  const int l = (ph - 2) / 6, s = (ph - 2) % 6;
  switch (s) {
    case 0: phase_inproj(p, l, smem, tid); break;
    case 1: phase_prep(p, l, smem, tid); break;
    case 2: phase_mix(p, l, smem, tid); break;
    case 3: phase_merge(p, l, smem, tid); break;
    case 4: phase_outproj(p, l, smem, tid); break;
    default: phase_lnf(p, l, tid); break;
  }
}

#endif

struct KArgs { const float* in[25]; float* out; char* ws; };

constexpr size_t al256(size_t b) { return (b + 255) & ~(size_t)255; }
constexpr size_t OFF_XN = 0;
constexpr size_t OFF_PK = OFF_XN + al256((size_t)R * 1024 * 2);
constexpr size_t OFF_PT = OFF_PK + al256((size_t)R * PKW * 2);
constexpr size_t OFF_VTAD = OFF_PT + al256((size_t)R * PTW * 2);
constexpr size_t OFF_QB = OFF_VTAD + al256((size_t)NBATCH * 384 * SEQA * 2);
constexpr size_t OFF_KB = OFF_QB + al256((size_t)R * 384 * 2);
constexpr size_t OFF_VTB = OFF_KB + al256((size_t)NBATCH * 4 * SEQA * 96 * 2);
constexpr size_t OFF_QD = OFF_VTB + al256((size_t)NBATCH * 256 * SEQA * 2);
constexpr size_t OFF_KD = OFF_QD + al256((size_t)R * 256 * 2);
constexpr size_t OFF_G = OFF_KD + al256((size_t)NBATCH * 2 * SEQA * 64 * 2);
constexpr size_t OFF_WTIN = OFF_G + al256((size_t)R * 1024 * 2);
constexpr size_t OFF_WTM = OFF_WTIN + al256((size_t)2 * 3072 * 1024 * 2);
constexpr size_t OFF_WTUQ = OFF_WTM + al256((size_t)2 * 4096 * 1024 * 2);
constexpr size_t OFF_WTUKV = OFF_WTUQ + al256((size_t)2 * 384 * 256 * 2);
constexpr size_t OFF_WTA = OFF_WTUKV + al256((size_t)2 * 512 * 128 * 2);
constexpr size_t OFF_WTX = OFF_WTA + al256((size_t)2 * 8 * 4096 * 2);
constexpr size_t OFF_WTBR = OFF_WTX + al256((size_t)2 * 8 * 4096 * 2);
constexpr size_t OFF_WTOUT = OFF_WTBR + al256((size_t)2 * 4 * 1024 * 256 * 2);
constexpr size_t OFF_MOD = OFF_WTOUT + al256((size_t)2 * 1024 * 1024 * 2);
constexpr size_t OFF_AGG = OFF_MOD + al256((size_t)2 * 9 * 3072 * 4);
constexpr size_t OFF_CTXV = OFF_AGG + al256((size_t)NBATCH * 68 * 2 * 256 * 8);
constexpr size_t OFF_ROPEB = OFF_CTXV + al256((size_t)NBATCH * CTXL * 1024 * 4);
constexpr size_t OFF_ROPED = OFF_ROPEB + al256(64 * 8 * 2 * 4);
constexpr size_t OFF_SG = OFF_ROPED + al256(64 * 16 * 2 * 4);
constexpr size_t OFF_BAR = OFF_SG;
constexpr size_t WS_END = OFF_BAR + 32768;

DI int launder_i(int v) { asm volatile("" : "+v"(v)); return v; }
DI Params make_params(const KArgs& ka) {
  char* ws = ka.ws; float* out = ka.out;
  Params p;
  const float** pin = (const float**)&p;
#pragma unroll
  for (int i = 0; i < 25; i++) pin[i] = ka.in[i];
  p.out = out;
  p.xn = (u16*)(ws + OFF_XN); p.Pk = (u16*)(ws + OFF_PK); p.Pt = (u16*)(ws + OFF_PT); p.VtAD = (u16*)(ws + OFF_VTAD);
  p.QB = (u16*)(ws + OFF_QB); p.KB = (u16*)(ws + OFF_KB); p.VtB = (u16*)(ws + OFF_VTB); p.QD = (u16*)(ws + OFF_QD); p.KD = (u16*)(ws + OFF_KD); p.G = (u16*)(ws + OFF_G);
  p.WtIn = (u16*)(ws + OFF_WTIN); p.WtM = (u16*)(ws + OFF_WTM); p.WtUq = (u16*)(ws + OFF_WTUQ); p.WtUkv = (u16*)(ws + OFF_WTUKV);
  p.WtA = (u16*)(ws + OFF_WTA); p.WtX = (u16*)(ws + OFF_WTX); p.WtBr = (u16*)(ws + OFF_WTBR); p.WtOut = (u16*)(ws + OFF_WTOUT);
  p.mod = (float*)(ws + OFF_MOD); p.agg = (float*)(ws + OFF_AGG); p.ctxV = (float*)(ws + OFF_CTXV); p.ropeB = (float*)(ws + OFF_ROPEB); p.ropeD = (float*)(ws + OFF_ROPED); p.sgbuf = ws + OFF_SG; p.bar = (unsigned*)(ws + OFF_BAR);
  return p;
}

#define XB_TMO      128
#define XB_XCNT(j)  (256  + 64 * (j))
#define XB_XSUB(j)  (1280 + 64 * (j))
#define XB_XGEN(j)  (2304 + 64 * (j))
#define XB_TOP      3328
#define XB_TOPGEN   3392
#define XCD_BAR_WORDS 3456
#define XB_SPIN_CAP (1u << 24)
DI unsigned xb_ld(unsigned* p) { return __hip_atomic_load(p, __ATOMIC_RELAXED, __HIP_MEMORY_SCOPE_AGENT); }
DI unsigned xb_add(unsigned* p, unsigned v) { return __hip_atomic_fetch_add(p, v, __ATOMIC_RELAXED, __HIP_MEMORY_SCOPE_AGENT); }
DI unsigned xb_xcc_id() { return (unsigned)__builtin_amdgcn_s_getreg((3 << 11) | 20) & 0xFu; }
#define XB_SPIN(cond, bar) do { unsigned _sp = 0; while (cond) { __builtin_amdgcn_s_sleep(1); \
    if ((++_sp & 255u) == 0u) { if (xb_ld(&(bar)[XB_TMO])) break; if (_sp > XB_SPIN_CAP) { atomicAdd(&(bar)[XB_TMO], 1u); break; } } } } while (0)

DI void xcd_census(unsigned* bar, unsigned x, unsigned& nloc, unsigned& nx) {
  const unsigned G = gridDim.x;
  unsigned sum, cnt, mine, sp = 0u;
  for (;;) {
    sum = 0u; cnt = 0u; mine = 0u;
#pragma unroll
    for (unsigned j = 0; j < 16; ++j) { const unsigned c = xb_ld(&bar[XB_XCNT(j)]); sum += c; cnt += (c > 0u) ? 1u : 0u; mine = (j == x) ? c : mine; }
    if (sum == G) break;
    __builtin_amdgcn_s_sleep(1);
    if ((++sp & 255u) == 0u) { if (xb_ld(&bar[XB_TMO])) break; if (sp > XB_SPIN_CAP) { atomicAdd(&bar[XB_TMO], 1u); break; } }
  }
  nloc = mine > 0u ? mine : 1u; nx = cnt > 0u ? cnt : 1u;
}

DI void xcd_barrier(unsigned* bar, unsigned x, volatile unsigned* st) {
  asm volatile("s_waitcnt vmcnt(0)" ::: "memory");
  __syncthreads();
  if (threadIdx.x == 0) {
    __builtin_amdgcn_s_waitcnt(0);
    unsigned nloc = st[0], nx = st[1];
    if (nloc == 0u) { xcd_census(bar, x, nloc, nx); st[0] = nloc; st[1] = nx; }
    const unsigned old = xb_add(&bar[XB_XSUB(x)], 1u);
    const unsigned gen = old / nloc;
    if (old + 1u == (gen + 1u) * nloc) {
      __builtin_amdgcn_fence(__ATOMIC_RELEASE, "agent");
      asm volatile("s_waitcnt vmcnt(0)" ::: "memory");
      const unsigned og = xb_add(&bar[XB_TOP], 1u);
      const unsigned tg = og / nx;
      if (og + 1u == (tg + 1u) * nx) xb_add(&bar[XB_TOPGEN], 1u);
      else XB_SPIN(xb_ld(&bar[XB_TOPGEN]) == tg, bar);
      __builtin_amdgcn_fence(__ATOMIC_ACQUIRE, "agent");
      xb_add(&bar[XB_XGEN(x)], 1u);
      asm volatile("s_waitcnt vmcnt(0)" ::: "memory");
    } else {
      XB_SPIN(xb_ld(&bar[XB_XGEN(x)]) == gen, bar);
      __builtin_amdgcn_fence(__ATOMIC_ACQUIRE, "agent");
      asm volatile("s_waitcnt vmcnt(0)" ::: "memory");
    }
  }
  __syncthreads();
}

__global__ void __launch_bounds__(256, 2) mega_kernel(KArgs ka) {
  __shared__ __attribute__((aligned(16))) char smem[SMEM_BYTES];
  __shared__ uint4 xb_words;
  cg::grid_group grid = cg::this_grid();
  const int tid = threadIdx.x;
  unsigned* const bar = (unsigned*)(ka.ws + OFF_BAR);
  if (tid == 0) xb_words = make_uint4(0u, 0u, 0u, 0u);
  if (ka.ws == nullptr) grid.sync();
  if (tid == 0) (void)xb_add(&((unsigned*)(ka.ws + OFF_BAR))[XB_XCNT(xb_xcc_id())], 1u);
#define GRID_BAR() xcd_barrier((unsigned*)(ka.ws + OFF_BAR), xb_xcc_id(), (volatile unsigned*)&xb_words)
  { Params p = make_params(ka); phase0(p, smem, launder_i(tid)); } GRID_BAR();
  { Params p = make_params(ka); phase_ln0(p, launder_i(tid)); } GRID_BAR();
#pragma unroll 1
  for (int l = 0; l < 2; l++) {
    { Params p = make_params(ka); phase_inproj(p, l, smem, launder_i(tid)); } GRID_BAR();
    { Params p = make_params(ka); phase_prep(p, l, smem, launder_i(tid)); } GRID_BAR();
    { Params p = make_params(ka); phase_mix(p, l, smem, launder_i(tid)); } GRID_BAR();
    { Params p = make_params(ka); phase_merge(p, l, smem, launder_i(tid)); } GRID_BAR();
    { Params p = make_params(ka); phase_outproj(p, l, smem, launder_i(tid)); } GRID_BAR();
    { Params p = make_params(ka); phase_lnf(p, l, launder_i(tid)); }
    if (l == 0) GRID_BAR();
  }
#undef GRID_BAR
}

#if MULTI
__global__ void __launch_bounds__(256, 2) phase_kernel(KArgs ka, int ph) {
  __shared__ __attribute__((aligned(16))) char smem[SMEM_BYTES];
  Params p = make_params(ka);
  run_phase(p, ph, smem, threadIdx.x);
}

#endif

extern "C" void kernel_launch(void* const* d_in, const int* in_sizes, int n_in, void* d_out, int out_size, void* d_ws, size_t ws_size, hipStream_t stream) {
  static int grid_blocks = 0;
  if (!grid_blocks) {
    int dev = 0, cus = 0, per_cu = 0;
    hipGetDevice(&dev);
    hipDeviceGetAttribute(&cus, hipDeviceAttributeMultiprocessorCount, dev);
    hipOccupancyMaxActiveBlocksPerMultiprocessor(&per_cu, mega_kernel, 256, 0);
    if (per_cu < 1) per_cu = 1;
    if (per_cu > 2) per_cu = 2;
    grid_blocks = cus * per_cu;
  }
  if (WS_END > ws_size) { fprintf(stderr, "kernel_launch: workspace too small: need %zu, have %zu\n", (size_t)WS_END, ws_size); return; }
  KArgs ka{};
  for (int i = 0; i < 25; i++) ka.in[i] = (const float*)d_in[i];
  ka.out = (float*)d_out; ka.ws = (char*)d_ws;
#if MULTI
  for (int ph = 0; ph < NPHASE; ph++) hipLaunchKernelGGL(phase_kernel, dim3(grid_blocks), dim3(256), 0, stream, ka, ph);
#else
  (void)hipMemsetAsync((char*)d_ws + OFF_BAR, 0, 32768, stream);
  void* args[] = {&ka};
  hipError_t e = hipLaunchCooperativeKernel((void*)mega_kernel, dim3(grid_blocks), dim3(256), args, 0, stream);
  if (e != hipSuccess) fprintf(stderr, "cooperative launch failed: %s (grid %d)\n", hipGetErrorString(e), grid_blocks);
#endif
}
```
